# Optimizing an MI355X kernel written in HIP

```python
import math
import jax, jax.numpy as jnp
from jax import lax
import numpy as np


D_MODEL = 1024
BATCH = 2
SEQ = 16384
DEPTH = 2

HEAD_DIM = 64
MLSTM_WIDTH = D_MODEL // 4
MLSTM_HEADS = MLSTM_WIDTH // HEAD_DIM
MLSTM_CHUNK = 64
CONV_WIDTH = 4
S5_WIDTH = D_MODEL // 4
S5_GROUP_CH = 16
S5_GROUPS = S5_WIDTH // S5_GROUP_CH
S5_STATE = 64
S5_DT_MIN = 1e-3
S5_DT_MAX = 1e-1
ATTN_WIDTH = D_MODEL - MLSTM_WIDTH - S5_WIDTH
ATTN_HEADS = ATTN_WIDTH // HEAD_DIM
ATTN_BLOCK = 128
DILATED_PATTERNS = ((128, 1), (512, 4), (2048, 16))
REL_BUCKETS = 32
REL_MAX_EXACT = 16
REL_MAX_DIST = 2048
MEM_TOKENS = 256
MEM_HEADS = 4
MEM_HEAD_DIM = D_MODEL // MEM_HEADS
MOE_GROUPS = 4
EXPERTS_PER_GROUP = 8
N_EXPERTS = MOE_GROUPS * EXPERTS_PER_GROUP
TOP_K = 2
D_EXPERT = D_MODEL // 2
MOE_BLOCK = 128

IN_WIDTH = 2 * MLSTM_WIDTH + 2 * MLSTM_HEADS + S5_WIDTH + 3 * ATTN_WIDTH
RMS_EPS = 1e-6
NEG_INF = -1e30

kernel_name = 'hybrid_mlstm_s5_dilated_hmoe_block'

f32 = jnp.float32


def rms_norm(x, gain):
    xf = x.astype(f32)
    y = xf * lax.rsqrt(jnp.mean(xf * xf, axis=-1, keepdims=True) + RMS_EPS)
    return (y * gain.astype(f32)).astype(x.dtype)


def causal_depthwise_conv(x, w, b):
    k_w, c = w.shape
    y = lax.conv_general_dilated(x, w[:, None, :].astype(x.dtype), window_strides=(1,),
                                 padding=[(k_w - 1, 0)],
                                 dimension_numbers=('NWC', 'WIO', 'NWC'),
                                 feature_group_count=c)
    return y + b.astype(x.dtype)


def mlstm_chunkwise(q, k, v, log_i, log_f):
    B, H, S, Dh = q.shape
    L = MLSTM_CHUNK
    nc = S // L
    q = q.reshape(B, H, nc, L, Dh)
    k = k.reshape(B, H, nc, L, Dh)
    v = v.reshape(B, H, nc, L, Dh)
    log_i = log_i.reshape(B, H, nc, L)
    b = jnp.cumsum(log_f.reshape(B, H, nc, L), axis=-1)
    g = b[..., -1]
    a = g[..., None] - b + log_i

    def step(carry, xs):
        c_st, n_st, m_st = carry
        g_c, a_c, k_c, v_c = xs
        m_new = jnp.maximum(g_c + m_st, jnp.max(a_c, axis=-1))
        decay = jnp.exp(g_c + m_st - m_new)
        w = jnp.exp(a_c - m_new[..., None])
        c_new = decay[..., None, None] * c_st + jnp.einsum('bhl,bhld,bhle->bhde', w, k_c, v_c)
        n_new = decay[..., None] * n_st + jnp.einsum('bhl,bhld->bhd', w, k_c)
        return (c_new, n_new, m_new), (c_st, n_st, m_st)

    init = (jnp.zeros((B, H, Dh, Dh), f32), jnp.zeros((B, H, Dh), f32), jnp.zeros((B, H), f32))
    xs = (jnp.moveaxis(g, 2, 0), jnp.moveaxis(a, 2, 0), jnp.moveaxis(k, 2, 0), jnp.moveaxis(v, 2, 0))
    _, (c_prev, n_prev, m_prev) = lax.scan(step, init, xs)
    c_prev = jnp.moveaxis(c_prev, 0, 2)
    n_prev = jnp.moveaxis(n_prev, 0, 2)
    m_prev = jnp.moveaxis(m_prev, 0, 2)

    causal = np.tril(np.ones((L, L), dtype=bool))
    d_mat = jnp.where(causal, b[..., :, None] - b[..., None, :] + log_i[..., None, :], -jnp.inf)
    m_inter = b + m_prev[..., None]
    m_t = jnp.maximum(m_inter, jnp.max(d_mat, axis=-1))
    w_intra = jnp.exp(d_mat - m_t[..., None]) * jnp.einsum('bhcld,bhcsd->bhcls', q, k)
    inter = jnp.exp(m_inter - m_t)
    num = inter[..., None] * jnp.einsum('bhcld,bhcde->bhcle', q, c_prev) \
        + jnp.einsum('bhcls,bhcse->bhcle', w_intra, v)
    den = inter * jnp.einsum('bhcld,bhcd->bhcl', q, n_prev) + jnp.sum(w_intra, axis=-1)
    h = num / jnp.maximum(jnp.abs(den), jnp.exp(-m_t))[..., None]
    return h.reshape(B, H, S, Dh)


def mlstm_mixer(u, o_pre, i_pre, f_pre, conv_w, conv_b, wq, wk, wv, gate_bias, norm_gain, skip):
    B, S, W = u.shape
    H, Dh = MLSTM_HEADS, HEAD_DIM
    c = jax.nn.silu(causal_depthwise_conv(u, conv_w, conv_b))
    ch = c.reshape(B, S, H, Dh).astype(f32)
    uh = u.reshape(B, S, H, Dh).astype(f32)
    q = jnp.einsum('bshd,hde->bhse', ch, wq.astype(f32)) * (Dh ** -0.5)
    k = jnp.einsum('bshd,hde->bhse', ch, wk.astype(f32))
    v = jnp.einsum('bshd,hde->bhse', uh, wv.astype(f32))
    gb = gate_bias.astype(f32)
    log_i = jnp.transpose(i_pre.astype(f32) + gb[:H], (0, 2, 1))
    log_f = jnp.transpose(jax.nn.log_sigmoid(f_pre.astype(f32) + gb[H:]), (0, 2, 1))
    h = jnp.transpose(mlstm_chunkwise(q, k, v, log_i, log_f), (0, 2, 1, 3))
    h = h * lax.rsqrt(jnp.mean(h * h, axis=-1, keepdims=True) + RMS_EPS)
    h = h.reshape(B, S, W) * norm_gain.astype(f32) + skip.astype(f32) * c.astype(f32)
    return (jax.nn.sigmoid(o_pre.astype(f32)) * h).astype(u.dtype)


def s5_mixer(u, a_re, a_im, log_dt, b_re, b_im, c_re, c_im, d_skip, w_glu, b_glu):
    B, S, W = u.shape
    G, Hc, P = S5_GROUPS, S5_GROUP_CH, S5_STATE
    uf = u.astype(f32).reshape(B, S, G, Hc)
    a_re = a_re.astype(f32)
    a_im = a_im.astype(f32)
    dt = jnp.exp(log_dt.astype(f32))[:, None]
    mag = jnp.exp(a_re * dt)
    ab_re = mag * jnp.cos(a_im * dt)
    ab_im = mag * jnp.sin(a_im * dt)
    den = a_re * a_re + a_im * a_im
    xr, yi = ab_re - 1.0, ab_im
    coef_re = (xr * a_re + yi * a_im) / den
    coef_im = (yi * a_re - xr * a_im) / den
    b_re = b_re.astype(f32)
    b_im = b_im.astype(f32)
    bb_re = coef_re[..., None] * b_re - coef_im[..., None] * b_im
    bb_im = coef_re[..., None] * b_im + coef_im[..., None] * b_re
    bu_re = jnp.einsum('bsgh,gph->bsgp', uf, bb_re)
    bu_im = jnp.einsum('bsgh,gph->bsgp', uf, bb_im)
    a_seq_re = jnp.broadcast_to(ab_re, (1, S, G, P))
    a_seq_im = jnp.broadcast_to(ab_im, (1, S, G, P))

    def combine(e1, e2):
        a1r, a1i, b1r, b1i = e1
        a2r, a2i, b2r, b2i = e2
        return (a2r * a1r - a2i * a1i, a2r * a1i + a2i * a1r,
                a2r * b1r - a2i * b1i + b2r, a2r * b1i + a2i * b1r + b2i)

    _, _, st_re, st_im = lax.associative_scan(combine, (a_seq_re, a_seq_im, bu_re, bu_im), axis=1)
    y = jnp.einsum('bsgp,ghp->bsgh', st_re, c_re.astype(f32)) \
        - jnp.einsum('bsgp,ghp->bsgh', st_im, c_im.astype(f32)) \
        + d_skip.astype(f32) * uf
    z = jax.nn.gelu(y.reshape(B, S, W))
    out = z * jax.nn.sigmoid(z @ w_glu.astype(f32) + b_glu.astype(f32))
    return out.astype(u.dtype)


def t5_bucket(dist):
    exact = dist < REL_MAX_EXACT
    large = REL_MAX_EXACT + (np.log(np.maximum(dist, 1) / REL_MAX_EXACT)
                             / np.log(REL_MAX_DIST / REL_MAX_EXACT)
                             * (REL_BUCKETS - REL_MAX_EXACT)).astype(np.int32)
    large = np.minimum(large, REL_BUCKETS - 1)
    return np.where(exact, dist, large).astype(np.int32)


def dilated_bias_mask(window, dil, n_blocks, rel_table):
    n_back = window // dil
    i = np.arange(ATTN_BLOCK)[:, None]
    j = np.arange(2 * ATTN_BLOCK)[None, :]
    off = ATTN_BLOCK + i - j
    band = (off >= 0) & (off <= n_back)
    bucket = t5_bucket(np.clip(off, 0, None) * dil)
    bias = jnp.transpose(rel_table.astype(f32)[bucket], (2, 0, 1))
    key_valid = (np.arange(n_blocks)[:, None] > 0) | (j >= ATTN_BLOCK)
    mask = band[None, None, None, None] & key_valid[None, :, None, None, None, :]
    return bias, mask


def prev_block(x):
    return jnp.concatenate([jnp.zeros_like(x[:, :1]), x[:, :-1]], axis=1)


def dilated_attention(q, k, v, rel_table):
    B, S, H, Dh = q.shape
    q = q.astype(f32) * (Dh ** -0.5)
    k = k.astype(f32)
    v = v.astype(f32)
    outs, lses = [], []
    for window, dil in DILATED_PATTERNS:
        span = ATTN_BLOCK * dil
        s_pad = -(-S // span) * span
        nb = s_pad // span
        pad_w = ((0, 0), (0, s_pad - S), (0, 0), (0, 0))
        qb = jnp.pad(q, pad_w).reshape(B, nb, ATTN_BLOCK, dil, H, Dh)
        kb = jnp.pad(k, pad_w).reshape(B, nb, ATTN_BLOCK, dil, H, Dh)
        vb = jnp.pad(v, pad_w).reshape(B, nb, ATTN_BLOCK, dil, H, Dh)
        kw = jnp.concatenate([prev_block(kb), kb], axis=2)
        vw = jnp.concatenate([prev_block(vb), vb], axis=2)
        bias, mask = dilated_bias_mask(window, dil, nb, rel_table)
        s = jnp.einsum('bnirhe,bnjrhe->bnrhij', qb, kw) + bias
        s = jnp.where(mask, s, NEG_INF)
        m = jnp.max(s, axis=-1, keepdims=True)
        p = jnp.exp(s - m)
        l = jnp.sum(p, axis=-1, keepdims=True)
        o = jnp.einsum('bnrhij,bnjrhe->bnirhe', p / l, vw)
        lse = jnp.transpose((m + jnp.log(l))[..., 0], (0, 1, 4, 2, 3))
        outs.append(o.reshape(B, s_pad, H, Dh)[:, :S])
        lses.append(lse.reshape(B, s_pad, H)[:, :S])
    w = jax.nn.softmax(jnp.stack(lses), axis=0)
    return jnp.sum(w[..., None] * jnp.stack(outs), axis=0)


def memory_cross_attention(xn, memn, w_q, w_kv, w_o):
    B, S, D = xn.shape
    M = memn.shape[1]
    q = (xn @ w_q).reshape(B, S, MEM_HEADS, MEM_HEAD_DIM)
    k, v = jnp.split(memn @ w_kv, 2, axis=-1)
    k = k.reshape(B, M, MEM_HEADS, MEM_HEAD_DIM)
    v = v.reshape(B, M, MEM_HEADS, MEM_HEAD_DIM)
    s = jnp.einsum('bshe,bmhe->bhsm', q, k).astype(f32) * (MEM_HEAD_DIM ** -0.5)
    p = jax.nn.softmax(s, axis=-1).astype(v.dtype)
    o = jnp.einsum('bhsm,bmhe->bshe', p, v).reshape(B, S, D)
    return o @ w_o


def hier_moe(xn, w_group, b_group, w_expert, b_expert, w_gu, w_down):
    B, S, D = xn.shape
    T = B * S
    xt = xn.reshape(T, D)
    g_prob = jax.nn.softmax((xt @ w_group).astype(f32) + b_group.astype(f32), axis=-1)
    g_p, g_i = lax.top_k(g_prob, 1)
    e_logits = ((xt @ w_expert).astype(f32) + b_expert.astype(f32)).reshape(T, MOE_GROUPS, EXPERTS_PER_GROUP)
    e_logits = jnp.take_along_axis(e_logits, g_i[:, :, None], axis=1)[:, 0]
    e_p, e_i = lax.top_k(jax.nn.softmax(e_logits, axis=-1), TOP_K)
    gates = g_p * e_p / jnp.sum(e_p, axis=-1, keepdims=True)
    eid = (g_i * EXPERTS_PER_GROUP + e_i).reshape(-1)
    gate = gates.reshape(-1).astype(xt.dtype)
    tok = jnp.repeat(jnp.arange(T, dtype=jnp.int32), TOP_K)
    n_assign = T * TOP_K
    order = jnp.argsort(eid)
    eid_s, tok_s, gate_s = eid[order], tok[order], gate[order]
    counts = jnp.bincount(eid, length=N_EXPERTS)
    starts = jnp.cumsum(counts) - counts
    padded = (counts + MOE_BLOCK - 1) // MOE_BLOCK * MOE_BLOCK
    p_ends = jnp.cumsum(padded)
    p_starts = p_ends - padded
    dest = p_starts[eid_s] + jnp.arange(n_assign, dtype=jnp.int32) - starts[eid_s]
    n_blocks = -(-n_assign // MOE_BLOCK) + N_EXPERTS
    n_rows = n_blocks * MOE_BLOCK
    row_tok = jnp.full((n_rows,), T, jnp.int32).at[dest].set(tok_s)
    row_gate = jnp.zeros((n_rows,), xt.dtype).at[dest].set(gate_s)
    block_e = jnp.minimum(jnp.searchsorted(p_ends, jnp.arange(n_blocks) * MOE_BLOCK, side='right'),
                          N_EXPERTS - 1)
    x_rows = jnp.concatenate([xt, jnp.zeros((1, D), xt.dtype)], axis=0)[row_tok]
    x_rows = x_rows.reshape(n_blocks, MOE_BLOCK, D)

    def expert_block(args):
        xb, e = args
        a, b = jnp.split(xb @ w_gu[e], 2, axis=-1)
        return (jax.nn.silu(a) * b) @ w_down[e]

    y_rows = lax.map(expert_block, (x_rows, block_e)).reshape(n_rows, D)
    out = jnp.zeros((T + 1, D), xt.dtype).at[row_tok].add(y_rows * row_gate[:, None])[:T]
    return out.reshape(B, S, D)


def setup_inputs(seed: int = 0) -> dict:
    key = jax.random.key(seed)
    ks = iter(jax.random.split(key, 48))

    def nrm(shape, scale):
        return jax.random.normal(next(ks), shape, f32) * scale

    def gain(shape):
        return 1.0 + nrm(shape, 0.02)

    L, D = DEPTH, D_MODEL
    H, G, P, Hc = MLSTM_HEADS, S5_GROUPS, S5_STATE, S5_GROUP_CH
    n_idx = jnp.arange(P, dtype=f32)
    gate_bias = jnp.concatenate([nrm((L, H), 0.1),
                                 jnp.linspace(3.0, 6.0, H, dtype=f32)[None] + nrm((L, H), 0.1)], axis=-1)
    return {
        'x': nrm((BATCH, SEQ, D), 1.0),
        'mem': nrm((BATCH, MEM_TOKENS, D), 1.0),
        'rel_bias': nrm((REL_BUCKETS, ATTN_HEADS), 0.5),
        'norm_mix': gain((L, D)),
        'w_in': nrm((L, D, IN_WIDTH), D ** -0.5),
        'mlstm_conv_w': nrm((L, CONV_WIDTH, MLSTM_WIDTH), CONV_WIDTH ** -0.5),
        'mlstm_conv_b': nrm((L, MLSTM_WIDTH), 0.02),
        'mlstm_wq': nrm((L, H, HEAD_DIM, HEAD_DIM), HEAD_DIM ** -0.5),
        'mlstm_wk': nrm((L, H, HEAD_DIM, HEAD_DIM), HEAD_DIM ** -0.5),
        'mlstm_wv': nrm((L, H, HEAD_DIM, HEAD_DIM), HEAD_DIM ** -0.5),
        'mlstm_gate_bias': gate_bias,
        'mlstm_norm': gain((L, MLSTM_WIDTH)),
        'mlstm_skip': gain((L, MLSTM_WIDTH)),
        's5_a_re': -0.5 + nrm((L, G, P), 0.01),
        's5_a_im': math.pi * n_idx[None, None, :] + nrm((L, G, P), 0.01),
        's5_log_dt': jax.random.uniform(next(ks), (L, G), f32, math.log(S5_DT_MIN), math.log(S5_DT_MAX)),
        's5_b_re': nrm((L, G, P, Hc), (2.0 * Hc) ** -0.5),
        's5_b_im': nrm((L, G, P, Hc), (2.0 * Hc) ** -0.5),
        's5_c_re': nrm((L, G, Hc, P), (2.0 * P) ** -0.5),
        's5_c_im': nrm((L, G, Hc, P), (2.0 * P) ** -0.5),
        's5_d': nrm((L, G, Hc), 1.0),
        's5_w_glu': nrm((L, S5_WIDTH, S5_WIDTH), S5_WIDTH ** -0.5),
        's5_b_glu': nrm((L, S5_WIDTH), 0.02),
        's5_out_norm': gain((L, S5_WIDTH)),
        'attn_out_norm': gain((L, ATTN_WIDTH)),
        'w_out': nrm((L, D, D), D ** -0.5),
        'norm_xattn': gain((L, D)),
        'norm_mem': gain((L, D)),
        'xattn_w_q': nrm((L, D, D), D ** -0.5),
        'xattn_w_kv': nrm((L, D, 2 * D), D ** -0.5),
        'xattn_w_o': nrm((L, D, D), D ** -0.5),
        'norm_ffn': gain((L, D)),
        'router_w_group': nrm((L, D, MOE_GROUPS), D ** -0.5),
        'router_b_group': nrm((L, MOE_GROUPS), 0.01),
        'router_w_expert': nrm((L, D, N_EXPERTS), D ** -0.5),
        'router_b_expert': nrm((L, N_EXPERTS), 0.01),
        'expert_w_gu': nrm((L, N_EXPERTS, D, 2 * D_EXPERT), D ** -0.5),
        'expert_w_down': nrm((L, N_EXPERTS, D_EXPERT, D), D_EXPERT ** -0.5),
        'final_norm': gain((D,)),
    }


def reference(x, mem, rel_bias, norm_mix, w_in, mlstm_conv_w, mlstm_conv_b, mlstm_wq, mlstm_wk,
              mlstm_wv, mlstm_gate_bias, mlstm_norm, mlstm_skip, s5_a_re, s5_a_im, s5_log_dt,
              s5_b_re, s5_b_im, s5_c_re, s5_c_im, s5_d, s5_w_glu, s5_b_glu, s5_out_norm,
              attn_out_norm, w_out, norm_xattn, norm_mem, xattn_w_q, xattn_w_kv, xattn_w_o,
              norm_ffn, router_w_group, router_b_group, router_w_expert, router_b_expert,
              expert_w_gu, expert_w_down, final_norm):
    B, S, D = x.shape
    sizes = [MLSTM_WIDTH, MLSTM_WIDTH, MLSTM_HEADS, MLSTM_HEADS, S5_WIDTH,
             ATTN_WIDTH, ATTN_WIDTH, ATTN_WIDTH]
    split_at = [int(s) for s in np.cumsum(sizes)[:-1]]
    for l in range(DEPTH):
        proj = rms_norm(x, norm_mix[l]) @ w_in[l]
        m_u, m_o, m_i, m_f, s_u, a_q, a_k, a_v = jnp.split(proj, split_at, axis=-1)
        y_m = mlstm_mixer(m_u, m_o, m_i, m_f, mlstm_conv_w[l], mlstm_conv_b[l], mlstm_wq[l],
                          mlstm_wk[l], mlstm_wv[l], mlstm_gate_bias[l], mlstm_norm[l], mlstm_skip[l])
        y_s = s5_mixer(s_u, s5_a_re[l], s5_a_im[l], s5_log_dt[l], s5_b_re[l], s5_b_im[l],
                       s5_c_re[l], s5_c_im[l], s5_d[l], s5_w_glu[l], s5_b_glu[l])
        y_s = rms_norm(y_s, s5_out_norm[l])
        y_a = dilated_attention(a_q.reshape(B, S, ATTN_HEADS, HEAD_DIM),
                                a_k.reshape(B, S, ATTN_HEADS, HEAD_DIM),
                                a_v.reshape(B, S, ATTN_HEADS, HEAD_DIM), rel_bias)
        y_a = rms_norm(y_a.reshape(B, S, ATTN_WIDTH).astype(x.dtype), attn_out_norm[l])
        x = x + jnp.concatenate([y_m, y_s, y_a], axis=-1) @ w_out[l]
        x = x + memory_cross_attention(rms_norm(x, norm_xattn[l]), rms_norm(mem, norm_mem[l]),
                                       xattn_w_q[l], xattn_w_kv[l], xattn_w_o[l])
        x = x + hier_moe(rms_norm(x, norm_ffn[l]), router_w_group[l], router_b_group[l],
                         router_w_expert[l], router_b_expert[l], expert_w_gu[l], expert_w_down[l])
    return rms_norm(x, final_norm)
```

```cpp
#include <hip/hip_runtime.h>
#include <cstdio>
#include <cstdint>
#include <cmath>
namespace pg8 {
#define PG8_LAS __attribute__((address_space(3)))
typedef unsigned short bf16_t;
typedef short bf16x8 __attribute__((ext_vector_type(8)));
typedef float f32x4 __attribute__((ext_vector_type(4)));
typedef unsigned u32x4 __attribute__((ext_vector_type(4)));
constexpr int BM = 256, BK = 64, HALF = 128, HTB = HALF * BK * 2  , STAGE_BYTES = 8 * HTB, NXCD = 8, WGM = 8;

__host__ __device__ __forceinline__ int lds_byte(int r, int c) { const int st = (r >> 4) * 2 + (c >> 5), rr = r & 15, cc = c & 31, ob = rr * 64 + cc * 2; return st * 1024 + (ob ^ (((ob >> 9) & 1) << 5)); }
__host__ __device__ __forceinline__ void stage_rc(int b, int& R, int& C) { const int st = b / 1024, sb = b % 1024, swz = sb ^ (((sb >> 9) & 1) << 5); R = (st >> 1) * 16 + swz / 64; C = (st & 1) * 32 + (swz % 64) / 2; }
__host__ __device__ __forceinline__ int perm32(int rho) { const int n = rho >> 4, i = rho & 15; return 8 * (i >> 2) + 4 * n + (i & 3); }

struct Unit { int pm, pn; };
struct Gemm { const bf16_t* A; const bf16_t* Bt; int M, N, K; };

struct StaticOrder {
    int nM, nN, nwg, G, c;
    __host__ __device__ void init(int M, int N, int G_, int c_) { nM = M / BM; nN = N / BM; nwg = nM * nN; G = G_; c = c_; }
    __host__ __device__ bool next(int i, Unit& u) const {
        const long L = (long)i * G + c; if (L >= nwg) return false;
        int wgid = (int)L; { const int q = nwg / NXCD, r = nwg % NXCD, xcd = wgid % NXCD, off = wgid / NXCD; wgid = (xcd < r ? xcd * (q + 1) : r * (q + 1) + (xcd - r) * q) + off; }
        const int nig = WGM * nN, gid = wgid / nig, fm = gid * WGM, gsz = (nM - fm) < WGM ? (nM - fm) : WGM;
        u.pm = fm + ((wgid % nig) % gsz); u.pn = (wgid % nig) / gsz; return true;
    }
    __device__ __forceinline__ void a_ready(const Unit&) const {}
    __device__ __forceinline__ void done(const Unit&) const {}
};
typedef float f32x2e __attribute__((ext_vector_type(2))); typedef __bf16 bf16x2e __attribute__((ext_vector_type(2)));
__device__ __forceinline__ unsigned cvtpk(float lo, float hi) { f32x2e v = {lo, hi}; bf16x2e b = __builtin_convertvector(v, bf16x2e); return __builtin_bit_cast(unsigned, b); }
__device__ __forceinline__ float bflo(unsigned w) { return __uint_as_float(w << 16); }
__device__ __forceinline__ float bfhi(unsigned w) { return __uint_as_float(w & 0xffff0000u); }
__device__ __forceinline__ u32x4 pack8v(const f32x4& v0, const f32x4& v1) { u32x4 w; w.x = cvtpk(v0[0], v0[1]); w.y = cvtpk(v0[2], v0[3]); w.z = cvtpk(v1[0], v1[1]); w.w = cvtpk(v1[2], v1[3]); return w; }
__device__ __forceinline__ float ssq16(const float* p) {
    const f32x4 a = *(const f32x4*)p, b = *(const f32x4*)(p + 4), c = *(const f32x4*)(p + 8), d = *(const f32x4*)(p + 12);
    return (((a[0] + a[1]) + (a[2] + a[3])) + ((b[0] + b[1]) + (b[2] + b[3]))) + (((c[0] + c[1]) + (c[2] + c[3])) + ((d[0] + d[1]) + (d[2] + d[3])));
}
constexpr int PW_ = 2560;

struct EpiA {
    static constexpr bool PERM = true, AFTER_DRAIN = false;
    bf16_t* P; float* G; const float* rsa;
    __device__ __forceinline__ void operator()(const f32x4 (&acc)[2][2][4][2], const Unit& u, int wr, int wc, int fr, int fq) const {
        const int row0 = u.pm * BM + wr * 64 + fr;
        if (u.pn == 9) {
            if (wc == 0 && fq == 0) {
#pragma unroll
                for (int ai = 0; ai < 2; ++ai)
#pragma unroll
                    for (int m = 0; m < 4; ++m) { const int row = row0 + ai * HALF + m * 16; const float s = rsa[row];
                        *(f32x4*)(G + (size_t)row * 8) = acc[ai][0][m][0] * s; *(f32x4*)(G + (size_t)row * 8 + 4) = acc[ai][0][m][1] * s; }
            }
            return;
        }
        const int col0 = u.pn * BM + wc * 32 + 8 * fq;
#pragma unroll
        for (int ai = 0; ai < 2; ++ai)
#pragma unroll
            for (int m = 0; m < 4; ++m) { const int row = row0 + ai * HALF + m * 16; const float s = rsa[row]; bf16_t* rowp = P + (size_t)row * PW_ + col0;
#pragma unroll
                for (int bj = 0; bj < 2; ++bj) { const f32x4 v0 = acc[ai][bj][m][0] * s, v1 = acc[ai][bj][m][1] * s; *(u32x4*)(rowp + bj * HALF) = pack8v(v0, v1); } }
    }
};
struct EpiRes {
    static constexpr bool PERM = true, AFTER_DRAIN = false;
    bf16_t* X; float* ssq;
    __device__ __forceinline__ void operator()(const f32x4 (&acc)[2][2][4][2], const Unit& u, int wr, int wc, int fr, int fq) const {
        const int row0 = u.pm * BM + wr * 64 + fr, col0 = u.pn * BM + wc * 32 + 8 * fq;
#pragma unroll
        for (int ai = 0; ai < 2; ++ai)
#pragma unroll
            for (int m = 0; m < 4; ++m) { const int row = row0 + ai * HALF + m * 16; bf16_t* rowp = X + (size_t)row * 1024 + col0; float ss = 0.f;
#pragma unroll
                for (int bj = 0; bj < 2; ++bj) { const u32x4 o = *(const u32x4*)(rowp + bj * HALF);
                    f32x4 v0 = acc[ai][bj][m][0], v1 = acc[ai][bj][m][1];
                    v0[0] += bflo(o.x); v0[1] += bfhi(o.x); v0[2] += bflo(o.y); v0[3] += bfhi(o.y); v1[0] += bflo(o.z); v1[1] += bfhi(o.z); v1[2] += bflo(o.w); v1[3] += bfhi(o.w);
                    const u32x4 w = pack8v(v0, v1); *(u32x4*)(rowp + bj * HALF) = w;
                    const float a0 = bflo(w.x), a1 = bfhi(w.x), a2 = bflo(w.y), a3 = bfhi(w.y), a4 = bflo(w.z), a5 = bfhi(w.z), a6 = bflo(w.w), a7 = bfhi(w.w);
                    ss += ((a0 * a0 + a1 * a1) + (a2 * a2 + a3 * a3)) + ((a4 * a4 + a5 * a5) + (a6 * a6 + a7 * a7)); }
                ss += __shfl_xor(ss, 16); ss += __shfl_xor(ss, 32);
                if (fq == 0) ssq[(size_t)row * 16 + u.pn * 4 + wc] = ss; }
    }
};
struct EpiQ {
    static constexpr bool PERM = true, AFTER_DRAIN = false;
    bf16_t* Q; const float* ssq;
    __device__ __forceinline__ void operator()(const f32x4 (&acc)[2][2][4][2], const Unit& u, int wr, int wc, int fr, int fq) const {
        const int row0 = u.pm * BM + wr * 64 + fr, col0 = u.pn * BM + wc * 32 + 8 * fq;
#pragma unroll
        for (int ai = 0; ai < 2; ++ai)
#pragma unroll
            for (int m = 0; m < 4; ++m) { const int row = row0 + ai * HALF + m * 16; const float s = 1.0f / sqrtf(ssq16(ssq + (size_t)row * 16) * (1.0f / 1024.0f) + 1e-6f); bf16_t* rowp = Q + (size_t)row * 1024 + col0;
#pragma unroll
                for (int bj = 0; bj < 2; ++bj) { const f32x4 v0 = acc[ai][bj][m][0] * s, v1 = acc[ai][bj][m][1] * s; *(u32x4*)(rowp + bj * HALF) = pack8v(v0, v1); } }
    }
};
struct EpiKV {
    static constexpr bool PERM = true, AFTER_DRAIN = false;
    bf16_t* Km; bf16_t* Vt;
    __device__ __forceinline__ void operator()(const f32x4 (&acc)[2][2][4][2], const Unit& u, int wr, int wc, int fr, int fq) const {
        const int row0 = u.pm * BM + wr * 64 + fr; const int l = u.pn >> 3, ct = u.pn & 7;
        if (ct < 4) {
            const int col0 = ct * BM + wc * 32 + 8 * fq;
#pragma unroll
            for (int ai = 0; ai < 2; ++ai)
#pragma unroll
                for (int m = 0; m < 4; ++m) { const int row = row0 + ai * HALF + m * 16; bf16_t* rowp = Km + ((size_t)l * 512 + row) * 1024 + col0;
#pragma unroll
                    for (int bj = 0; bj < 2; ++bj) *(u32x4*)(rowp + bj * HALF) = pack8v(acc[ai][bj][m][0], acc[ai][bj][m][1]); }
        } else {
            const int col0 = (ct - 4) * BM + wc * 32 + 8 * fq;
#pragma unroll
            for (int ai = 0; ai < 2; ++ai)
#pragma unroll
                for (int m = 0; m < 4; ++m) { const int row = row0 + ai * HALF + m * 16; const int b = row >> 8, key = row & 255;
#pragma unroll
                    for (int bj = 0; bj < 2; ++bj) { const u32x4 w = pack8v(acc[ai][bj][m][0], acc[ai][bj][m][1]);
                        bf16_t* vp = Vt + (((size_t)l * 2 + b) * 1024 + col0 + bj * HALF) * 256 + key;
                        vp[0 * 256] = (bf16_t)(w.x & 0xffffu); vp[1 * 256] = (bf16_t)(w.x >> 16); vp[2 * 256] = (bf16_t)(w.y & 0xffffu); vp[3 * 256] = (bf16_t)(w.y >> 16);
                        vp[4 * 256] = (bf16_t)(w.z & 0xffffu); vp[5 * 256] = (bf16_t)(w.z >> 16); vp[6 * 256] = (bf16_t)(w.w & 0xffffu); vp[7 * 256] = (bf16_t)(w.w >> 16); } }
        }
    }
};
struct EpiGU {
    static constexpr bool PERM = true, AFTER_DRAIN = false;
    bf16_t* H; const float* rss;
    __device__ __forceinline__ void operator()(const f32x4 (&acc)[2][2][4][2], const Unit& u, int wr, int wc, int fr, int fq) const {
        const int row0 = u.pm * BM + wr * 64 + fr, col0 = (u.pn & 3) * HALF + wc * 32 + 8 * fq;
#pragma unroll
        for (int ai = 0; ai < 2; ++ai)
#pragma unroll
            for (int m = 0; m < 4; ++m) { const int row = row0 + ai * HALF + m * 16; const float s = rss[row]; f32x4 h0, h1;
#pragma unroll
                for (int j = 0; j < 4; ++j) { const float a0 = acc[ai][0][m][0][j] * s, b0 = acc[ai][1][m][0][j] * s, a1 = acc[ai][0][m][1][j] * s, b1 = acc[ai][1][m][1][j] * s;
                    h0[j] = a0 / (1.0f + __expf(-a0)) * b0; h1[j] = a1 / (1.0f + __expf(-a1)) * b1; }
                *(u32x4*)(H + (size_t)row * 512 + col0) = pack8v(h0, h1); }
    }
};
struct EpiDN {
    static constexpr bool PERM = true, AFTER_DRAIN = false;
    bf16_t* YP; const int* rowtok; const float* rowgate;
    __device__ __forceinline__ void operator()(const f32x4 (&acc)[2][2][4][2], const Unit& u, int wr, int wc, int fr, int fq) const {
        const int row0 = u.pm * BM + wr * 64 + fr, col0 = (u.pn & 3) * BM + wc * 32 + 8 * fq;
#pragma unroll
        for (int ai = 0; ai < 2; ++ai)
#pragma unroll
            for (int m = 0; m < 4; ++m) { const int row = row0 + ai * HALF + m * 16; const int tk = rowtok[row];
                if (tk >= 0 && tk < 65536) { const float gte = rowgate[row]; bf16_t* rowp = YP + ((size_t)(tk & 1) * 32768 + (size_t)(tk >> 1)) * 1024 + col0;
#pragma unroll
                    for (int bj = 0; bj < 2; ++bj) { const f32x4 v0 = acc[ai][bj][m][0] * gte, v1 = acc[ai][bj][m][1] * gte; *(u32x4*)(rowp + bj * HALF) = pack8v(v0, v1); } } }
    }
};
struct MoeOrder {
    const PG8_LAS int* tp; int G, c;
    __device__ __forceinline__ bool next(int i, Unit& u) const {
        const int L = i * G + c; const int R = tp[32]; if (L >= 4 * R) return false;
        const int rt = L >> 2; int e = 0;
#pragma unroll 1
        for (int k = 1; k < 32; ++k) e = (tp[k] <= rt) ? k : e;
        u.pm = rt; u.pn = e * 4 + (L & 3); return true;
    }
    __device__ __forceinline__ void a_ready(const Unit&) const {}
    __device__ __forceinline__ void done(const Unit&) const {}
};
template <class Epi, class Sched, bool ALIGN_EPI = false, bool SP2 = false>
__device__ __forceinline__ void gemm_phase(PG8_LAS unsigned char* lds, const Gemm g, const Sched& S, const Epi& E, int wave_id  ) {
    int lane_raw; asm volatile("v_mbcnt_lo_u32_b32 %0, -1, 0\n\tv_mbcnt_hi_u32_b32 %0, -1, %0" : "=v"(lane_raw));
    const int tid_raw = wave_id * 64 + lane_raw;
    const int tid = tid_raw, wid = __builtin_amdgcn_readfirstlane(tid >> 6), lane = tid & 63, wr = wid >> 2, wc = wid & 3, fr = lane & 15, fq = lane >> 4;
    const int K = g.K, nt = K / BK;
    unsigned voffA[2], voffB[2];
#pragma unroll
    for (int i = 0; i < 2; ++i) { int R, C; stage_rc(tid * 16 + i * 8192, R, C); const int Rb = Epi::PERM ? ((R & ~31) + perm32(R & 31)) : R;
        voffA[i] = (unsigned)(R * K + C) * 2u; voffB[i] = (unsigned)(Rb * K + C) * 2u; }
    const size_t kstep = (size_t)(BK * 2);
    const size_t hstep = (size_t)HALF * K * 2;
    const size_t tstep = 2 * hstep;
    const unsigned ldsw = (unsigned)wid * 1024u;
    const int aoff = lds_byte(wr * 64 + fr, fq * 8), boff = lds_byte(wc * 32 + fr, fq * 8);
#define PG8_SA(b, h) (((b) * 2 + (h)) * HTB)
#define PG8_SB(b, h) ((4 + (b) * 2 + (h)) * HTB)
#define PG8_STAGE(bufoff, gbase, voff) do { _Pragma("unroll") for (int _i = 0; _i < 2; ++_i) \
        __builtin_amdgcn_global_load_lds((const unsigned*)((const char*)(gbase) + (voff)[_i]), (PG8_LAS unsigned*)(lds + (bufoff) + ldsw + _i * 8192), 16, 0, 0); } while (0)
#define PG8_LDA(dst, b, h) do { _Pragma("unroll") for (int m = 0; m < 4; ++m) _Pragma("unroll") for (int k = 0; k < 2; ++k) dst[m][k] = *(const PG8_LAS bf16x8*)(lds + PG8_SA(b, h) + aoff + m * 2048 + k * 1024); } while (0)
#define PG8_LDB(dst, b, h) do { _Pragma("unroll") for (int n = 0; n < 2; ++n) _Pragma("unroll") for (int k = 0; k < 2; ++k) dst[n][k] = *(const PG8_LAS bf16x8*)(lds + PG8_SB(b, h) + boff + n * 2048 + k * 1024); } while (0)
#define PG8_MMA(ai, bj, At, Bt) do { __builtin_amdgcn_s_setprio(1); _Pragma("unroll") for (int m = 0; m < 4; ++m) _Pragma("unroll") for (int n = 0; n < 2; ++n) _Pragma("unroll") for (int k = 0; k < 2; ++k) \
        acc[ai][bj][m][n] = __builtin_amdgcn_mfma_f32_16x16x32_bf16(Bt[n][k], At[m][k], acc[ai][bj][m][n], 0, 0, 0); __builtin_amdgcn_s_setprio(0); } while (0)
#define PG8_WAIT_V(n) asm volatile("s_waitcnt vmcnt(" #n ")" ::: "memory")
#define PG8_WAIT_L(n) asm volatile("s_waitcnt lgkmcnt(" #n ")" ::: "memory")
#define PG8_BAR __builtin_amdgcn_s_barrier()
#define PG8_SCHED __builtin_amdgcn_sched_barrier(0)
    Unit cur, nxt; int ui = 0;
    if (!S.next(0, cur)) return;
    f32x4 acc[2][2][4][2];
#pragma unroll
    for (int a = 0; a < 2; ++a)
#pragma unroll
        for (int b = 0; b < 2; ++b)
#pragma unroll
            for (int m = 0; m < 4; ++m)
#pragma unroll
                for (int n = 0; n < 2; ++n) acc[a][b][m][n] = (f32x4){0.f, 0.f, 0.f, 0.f};
    bf16x8 At[4][2], B0[2][2], B1[2][2];
    const char* cA = (const char*)g.A + (size_t)cur.pm * tstep; const char* cB = (const char*)g.Bt + (size_t)cur.pn * tstep;
    S.a_ready(cur);
    if constexpr (SP2) {
        PG8_STAGE(PG8_SB(0, 0), cB, voffB); PG8_STAGE(PG8_SB(0, 1), cB + hstep, voffB); PG8_STAGE(PG8_SA(0, 0), cA, voffA); PG8_STAGE(PG8_SA(0, 1), cA + hstep, voffA);
        if (wr == 1) PG8_BAR;
        PG8_WAIT_V(2); PG8_BAR;
        PG8_STAGE(PG8_SB(1, 0), cB + kstep, voffB); PG8_STAGE(PG8_SA(1, 0), cA + kstep, voffA); PG8_STAGE(PG8_SB(1, 1), cB + hstep + kstep, voffB);
        PG8_WAIT_V(6); PG8_BAR;
    } else {
        PG8_STAGE(PG8_SB(0, 0), cB, voffB); PG8_STAGE(PG8_SA(0, 0), cA, voffA); PG8_STAGE(PG8_SB(0, 1), cB + hstep, voffB); PG8_STAGE(PG8_SA(0, 1), cA + hstep, voffA);
        if (wr == 1) PG8_BAR;
        PG8_WAIT_V(4); PG8_BAR;
        PG8_STAGE(PG8_SB(1, 0), cB + kstep, voffB); PG8_STAGE(PG8_SA(1, 0), cA + kstep, voffA); PG8_STAGE(PG8_SB(1, 1), cB + hstep + kstep, voffB);
        PG8_WAIT_V(6); PG8_BAR;
    }
    for (;;) {
        const bool has_next = S.next(ui + 1, nxt);
        const char* nA = has_next ? (const char*)g.A + (size_t)nxt.pm * tstep : cA; const char* nB = has_next ? (const char*)g.Bt + (size_t)nxt.pn * tstep : cB;
        for (int t = 0; t < nt; t += 2) {
            const bool last = (t == nt - 2);
            const char* a1 = cA + (size_t)(t + 1) * kstep;
            const char* a2 = last ? nA : cA + (size_t)(t + 2) * kstep; const char* b2 = last ? nB : cB + (size_t)(t + 2) * kstep;
            const char* a3 = a2 + kstep; const char* b3 = b2 + kstep;
            if (last && has_next) S.a_ready(nxt);
            if constexpr (SP2) {
            PG8_LDB(B0, 0, 0); PG8_LDB(B1, 0, 1); PG8_SCHED; PG8_LDA(At, 0, 0); PG8_STAGE(PG8_SA(1, 1), a1 + hstep, voffA);
            PG8_WAIT_V(8); PG8_WAIT_L(0); PG8_BAR; PG8_MMA(0, 0, At, B0); PG8_MMA(0, 1, At, B1); PG8_BAR; PG8_SCHED;
            PG8_LDA(At, 0, 1); PG8_STAGE(PG8_SB(0, 0), b2, voffB); PG8_STAGE(PG8_SB(0, 1), b2 + hstep, voffB); PG8_STAGE(PG8_SA(0, 0), a2, voffA);
            PG8_WAIT_V(8); PG8_WAIT_L(0); PG8_BAR; PG8_MMA(1, 0, At, B0); PG8_MMA(1, 1, At, B1); PG8_BAR; PG8_SCHED;
            PG8_LDB(B0, 1, 0); PG8_LDB(B1, 1, 1); PG8_SCHED; PG8_LDA(At, 1, 0); PG8_STAGE(PG8_SA(0, 1), a2 + hstep, voffA);
            PG8_WAIT_V(8); PG8_WAIT_L(0); PG8_BAR; PG8_MMA(0, 0, At, B0); PG8_MMA(0, 1, At, B1); PG8_BAR; PG8_SCHED;
            PG8_LDA(At, 1, 1); PG8_STAGE(PG8_SB(1, 0), b3, voffB); PG8_STAGE(PG8_SB(1, 1), b3 + hstep, voffB); PG8_STAGE(PG8_SA(1, 0), a3, voffA);
            PG8_WAIT_V(8); PG8_WAIT_L(0); PG8_BAR; PG8_MMA(1, 0, At, B0); PG8_MMA(1, 1, At, B1); PG8_BAR; PG8_SCHED;
            } else {
            PG8_LDB(B0, 0, 0); PG8_SCHED; PG8_LDA(At, 0, 0); PG8_STAGE(PG8_SA(1, 1), a1 + hstep, voffA);
            PG8_WAIT_L(8); PG8_BAR; PG8_WAIT_L(0); PG8_MMA(0, 0, At, B0); PG8_BAR; PG8_SCHED;
            PG8_LDB(B1, 0, 1); PG8_STAGE(PG8_SB(0, 0), b2, voffB);
            PG8_BAR; PG8_WAIT_L(0); PG8_MMA(0, 1, At, B1); PG8_BAR;
            PG8_LDA(At, 0, 1); PG8_STAGE(PG8_SA(0, 0), a2, voffA);
            PG8_BAR; PG8_WAIT_L(0); PG8_MMA(1, 0, At, B0); PG8_BAR; PG8_SCHED;
            PG8_STAGE(PG8_SB(0, 1), b2 + hstep, voffB);
            PG8_WAIT_V(6); PG8_BAR; PG8_MMA(1, 1, At, B1); PG8_BAR;
            PG8_LDB(B0, 1, 0); PG8_SCHED; PG8_LDA(At, 1, 0); PG8_STAGE(PG8_SA(0, 1), a2 + hstep, voffA);
            PG8_WAIT_L(8); PG8_BAR; PG8_WAIT_L(0); PG8_MMA(0, 0, At, B0); PG8_BAR; PG8_SCHED;
            PG8_LDB(B1, 1, 1); PG8_STAGE(PG8_SB(1, 0), b3, voffB);
            PG8_BAR; PG8_WAIT_L(0); PG8_MMA(0, 1, At, B1); PG8_BAR;
            PG8_LDA(At, 1, 1); PG8_STAGE(PG8_SA(1, 0), a3, voffA);
            PG8_BAR; PG8_WAIT_L(0); PG8_MMA(1, 0, At, B0); PG8_BAR; PG8_SCHED;
            PG8_STAGE(PG8_SB(1, 1), b3 + hstep, voffB);
            PG8_WAIT_V(6); PG8_BAR; PG8_MMA(1, 1, At, B1); PG8_BAR;
            }
        }
        if constexpr (ALIGN_EPI) { if (wr == 0) PG8_BAR; }
        if constexpr (!Epi::AFTER_DRAIN) { E(acc, cur, wr, wc, fr, fq); S.done(cur); }
        if (!has_next) break;
#pragma unroll
        for (int a = 0; a < 2; ++a)
#pragma unroll
            for (int b = 0; b < 2; ++b)
#pragma unroll
                for (int m = 0; m < 4; ++m)
#pragma unroll
                    for (int n = 0; n < 2; ++n) acc[a][b][m][n] = (f32x4){0.f, 0.f, 0.f, 0.f};
        cur = nxt; cA = nA; cB = nB; ++ui;
        if constexpr (ALIGN_EPI) { if (wr == 1) PG8_BAR; }
    }
    PG8_WAIT_V(0);
    if constexpr (!ALIGN_EPI) { if (wr == 0) PG8_BAR; }
    PG8_BAR;
    if constexpr (Epi::AFTER_DRAIN) { E.fused(acc, cur, wr, wc, fr, fq, lds, wid, lane); S.done(cur); }
#undef PG8_SA
#undef PG8_SB
#undef PG8_STAGE
#undef PG8_LDA
#undef PG8_LDB
#undef PG8_MMA
#undef PG8_WAIT_V
#undef PG8_WAIT_L
#undef PG8_BAR
#undef PG8_SCHED
}
}
#ifndef DBG_S5_SYNTH
#define DBG_S5_SYNTH 0
#endif
#ifndef DBG_S5_TWICE
#define DBG_S5_TWICE 0
#endif
#ifndef DBG_S5_NOPERM
#define DBG_S5_NOPERM 0
#endif
#ifndef DBG_S5_LDSFILL
#define DBG_S5_LDSFILL 0
#endif
#ifndef DBG_S5_NOCARRY
#define DBG_S5_NOCARRY 0
#endif
constexpr int NWAVES = 8;
constexpr int BATCH = 2, SEQ = 16384, T = BATCH * SEQ, D = 1024, NLAYER = 2;
constexpr int PW = 2560;
constexpr int PC_MU = 0, PC_MO = 256, PC_SU = 512, PC_Q = 768, PC_K = 1280, PC_V = 1792;
constexpr float RMS_EPS = 1e-6f;
constexpr int XS_ROWS = 73728;
constexpr size_t MiB = 1u << 20;
constexpr size_t WS_CTL = 0, CTL_ZERO_BYTES = 1 * MiB;
constexpr size_t WS_WIN = 1 * MiB, WS_WOUT = 11 * MiB, WS_WQ = 15 * MiB, WS_WO = 19 * MiB, WS_WKV = 23 * MiB, WS_WR = 31 * MiB, WS_TAB = 32 * MiB;
constexpr size_t WS_WGU = 36 * MiB, WS_WDN = 164 * MiB, WS_X = 228 * MiB, WS_RSA = 292 * MiB, WS_SSQ = 293 * MiB, WS_G = 295 * MiB, WS_LSE = 296 * MiB;
constexpr size_t WS_S5ST = 299 * MiB, WS_AMEM = 303 * MiB, WS_KMEM = 304 * MiB, WS_VT = 306 * MiB, WS_MISC = 308 * MiB, WS_MST = 312 * MiB;
constexpr size_t WS_P = 346 * MiB, WS_Y = 506 * MiB, WS_OP = 570 * MiB, WS_END = 666 * MiB;
constexpr size_t WS_Q = WS_P, WS_OX = WS_P + 64 * MiB, WS_XS = WS_P, WS_YP = WS_P, WS_H = WS_OP;
constexpr size_t TAB_BIAS = 0, TAB_MLW = 16384, TAB_S5AB = 212992, TAB_S5BB = 262144, TAB_S5CC = 393216, TAB_GLU = 524288, TAB_IMG = 1048576;
constexpr size_t MI_TOKE = 0, MI_TOKP = 262144, MI_TOKG = 524288, MI_TRS = 786432, MI_RT = 1048576, MI_RGATE = 1048576 + 524288, MI_RSS = 2097152, MI_MSC = 2097152 + 524288, MI_MPREV = 3 * 1048576, MI_PTAB = 3 * 1048576 + 65536;
constexpr int CW_TMO = 0, CW_BAR = 4096, CW_ECNT = 8192;
constexpr int RING_OFF = 0, RING_BYTES = 131072, LDSCTL_OFF = RING_BYTES, MISC_OFF = LDSCTL_OFF + 320, TP_OFF = LDSCTL_OFF + 1024;
constexpr int LDS_BYTES = 147456;

#define GAS __attribute__((address_space(1)))
#define LAS __attribute__((address_space(3)))
#define DI __device__ __forceinline__
typedef unsigned short bf16;
typedef unsigned v4u __attribute__((ext_vector_type(4)));
typedef unsigned v2u __attribute__((ext_vector_type(2)));
typedef float f32x4 __attribute__((ext_vector_type(4)));
typedef float f32x2 __attribute__((ext_vector_type(2)));
typedef float f32x16 __attribute__((ext_vector_type(16)));
typedef short bf16x8 __attribute__((ext_vector_type(8)));
typedef short s16x4 __attribute__((ext_vector_type(4)));
typedef GAS unsigned gu32;
#define RLX_AGENT __ATOMIC_RELAXED, __HIP_MEMORY_SCOPE_AGENT
#define LDS_WAIT() asm volatile("s_waitcnt lgkmcnt(0)" ::: "memory")
#define VM_WAIT() asm volatile("s_waitcnt vmcnt(0)" ::: "memory")
#define MFMA32(a, b, c) __builtin_amdgcn_mfma_f32_32x32x16_bf16((a), (b), (c), 0, 0, 0)
#define MFMA16(a, b, c) __builtin_amdgcn_mfma_f32_16x16x32_bf16((a), (b), (c), 0, 0, 0)
using pg8::cvtpk; using pg8::bflo; using pg8::bfhi;
DI unsigned pk2(float lo, float hi) { return cvtpk(lo, hi); }
DI bf16 f2bf(float f) { return (bf16)(cvtpk(f, 0.f) & 0xffffu); }
DI float bf2f(bf16 b) { return __uint_as_float(((unsigned)b) << 16); }
DI bf16x8 pack8(float a0, float a1, float a2, float a3, float a4, float a5, float a6, float a7) { v4u p; p.x = cvtpk(a0, a1); p.y = cvtpk(a2, a3); p.z = cvtpk(a4, a5); p.w = cvtpk(a6, a7); return __builtin_bit_cast(bf16x8, p); }
DI bf16x8 packstep(const f32x16& x, int s) { return s == 0 ? pack8(x[0], x[1], x[2], x[3], x[4], x[5], x[6], x[7]) : pack8(x[8], x[9], x[10], x[11], x[12], x[13], x[14], x[15]); }
DI int crow(int r, int hi) { return (r & 3) + 8 * (r >> 2) + 4 * hi; }
DI void unpack8(const v4u& w, float (&f)[8]) { f[0] = bflo(w.x); f[1] = bfhi(w.x); f[2] = bflo(w.y); f[3] = bfhi(w.y); f[4] = bflo(w.z); f[5] = bfhi(w.z); f[6] = bflo(w.w); f[7] = bfhi(w.w); }
DI float shx(float v, int m, int lane) { return __builtin_bit_cast(float, __builtin_amdgcn_ds_bpermute((lane ^ m) << 2, __builtin_bit_cast(int, v))); }
DI float shl_from(float v, int src) { return __builtin_bit_cast(float, __builtin_amdgcn_ds_bpermute(src << 2, __builtin_bit_cast(int, v))); }
DI float wave_sum(float v, int lane) {
#pragma unroll
    for (int o = 1; o < 64; o <<= 1) v += shx(v, o, lane);
    return v;
}
DI float wave_max(float v, int lane) {
#pragma unroll
    for (int o = 1; o < 64; o <<= 1) v = fmaxf(v, shx(v, o, lane));
    return v;
}
DI s16x4 vtr(const LAS unsigned char* p) { typedef short v4i16_t __attribute__((ext_vector_type(4))); return __builtin_bit_cast(s16x4, __builtin_amdgcn_ds_read_tr16_b64_v4i16((LAS v4i16_t*)p)); }
DI float sigmoidf_(float x) { return 1.0f / (1.0f + __expf(-x)); }
#define XB_TMO      128
#define XB_XCNT(j)  (256  + 64 * (j))
#define XB_XSUB(j)  (1280 + 64 * (j))
#define XB_XGEN(j)  (2304 + 64 * (j))
#define XB_TOP      3328
#define XB_TOPGEN   3392
#define XCD_BAR_WORDS 3456
#define XB_SPIN_CAP (1u << 18)

__device__ __forceinline__ unsigned xb_ld(unsigned* p)              { return __hip_atomic_load(p, __ATOMIC_RELAXED, __HIP_MEMORY_SCOPE_AGENT); }
__device__ __forceinline__ unsigned xb_add(unsigned* p, unsigned v) { return __hip_atomic_fetch_add(p, v, __ATOMIC_RELAXED, __HIP_MEMORY_SCOPE_AGENT); }
__device__ __forceinline__ unsigned xb_xcc_id() { return (unsigned)__builtin_amdgcn_s_getreg((3 << 11) | 20) & 0xFu; }
#define XB_SPIN(cond, bar) do { unsigned _sp = 0; while (cond) { __builtin_amdgcn_s_sleep(1); \
    if ((++_sp & 255u) == 0u) { if (xb_ld(&(bar)[XB_TMO])) break; if (_sp > XB_SPIN_CAP) { atomicAdd(&(bar)[XB_TMO], 1u); break; } } } } while (0)

struct XcdBarrier {
    unsigned* bar; unsigned x;
    volatile LAS unsigned* st;
};

__device__ __forceinline__ XcdBarrier xcd_barrier_post(unsigned* bar, volatile LAS unsigned* st) {
    XcdBarrier b; b.bar = bar; b.x = xb_xcc_id(); b.st = st;
    if (threadIdx.x == 0) (void)xb_add(&bar[XB_XCNT(b.x)], 1u);
    return b;
}
__device__ __forceinline__ void xcd_barrier_complete(unsigned* bar, unsigned x, unsigned& nloc, unsigned& nx) {
    const unsigned G = gridDim.x * gridDim.y * gridDim.z;
    unsigned sum, cnt, mine, sp = 0u;
    for (;;) {
        sum = 0u; cnt = 0u; mine = 0u;
#pragma unroll
        for (unsigned j = 0; j < 16; ++j) { const unsigned c = xb_ld(&bar[XB_XCNT(j)]); sum += c; cnt += (c > 0u) ? 1u : 0u; mine = (j == x) ? c : mine; }
        if (sum == G) break;
        __builtin_amdgcn_s_sleep(1);
        if ((++sp & 255u) == 0u) { if (xb_ld(&bar[XB_TMO])) break; if (sp > XB_SPIN_CAP) { atomicAdd(&bar[XB_TMO], 1u); break; } }
    }
    nloc = mine > 0u ? mine : 1u; nx = cnt > 0u ? cnt : 1u;
}

__device__ __forceinline__ void xcd_barrier(const XcdBarrier& b) {
    asm volatile("s_waitcnt vmcnt(0)" ::: "memory");
    __syncthreads();
    if (threadIdx.x == 0) {
        unsigned* bar = b.bar;
        __builtin_amdgcn_s_waitcnt(0);
        unsigned nloc = b.st[0], nx = b.st[1];
        if (nloc == 0u) { xcd_barrier_complete(bar, b.x, nloc, nx); b.st[0] = nloc; b.st[1] = nx; }
        const unsigned old = xb_add(&bar[XB_XSUB(b.x)], 1u);
        const unsigned gen = old / nloc;
        if (old + 1u == (gen + 1u) * nloc) {
            __builtin_amdgcn_fence(__ATOMIC_RELEASE, "agent");
            asm volatile("s_waitcnt vmcnt(0)" ::: "memory");
            const unsigned og = xb_add(&bar[XB_TOP], 1u);
            const unsigned tg = og / nx;
            if (og + 1u == (tg + 1u) * nx) xb_add(&bar[XB_TOPGEN], 1u);
            else XB_SPIN(xb_ld(&bar[XB_TOPGEN]) == tg, bar);
            __builtin_amdgcn_fence(__ATOMIC_ACQUIRE, "agent");
            xb_add(&bar[XB_XGEN(b.x)], 1u);
            asm volatile("s_waitcnt vmcnt(0)" ::: "memory");
        } else {
            XB_SPIN(xb_ld(&bar[XB_XGEN(b.x)]) == gen, bar);
            __builtin_amdgcn_fence(__ATOMIC_ACQUIRE, "agent");
            asm volatile("s_waitcnt vmcnt(0)" ::: "memory");
        }
    }
    __syncthreads();
}
struct Args { const float* in[39]; float* out; unsigned char* ws; };
enum { I_X = 0, I_MEM, I_REL, I_NMIX, I_WIN, I_CONVW, I_CONVB, I_MWQ, I_MWK, I_MWV, I_MGB, I_MNORM, I_MSKIP, I_S5ARE, I_S5AIM, I_S5DT, I_S5BRE, I_S5BIM, I_S5CRE, I_S5CIM,
       I_S5D, I_S5WGLU, I_S5BGLU, I_S5ONORM, I_AONORM, I_WOUT, I_NXATTN, I_NMEM, I_XWQ, I_XWKV, I_XWO, I_NFFN, I_RWG, I_RBG, I_RWE, I_RBE, I_EWGU, I_EWDN, I_FNORM };

struct Frame {
    LAS unsigned char* lds;
    gu32* ctl;
    int tid, lane, wave, vcu, G;
};

template <class F> DI void tr_item(bf16* WT, int K, LAS float* scr, int kb, int nb, int lane, const F& f) {
    const int k0 = 64 * kb, n0 = 32 * nb, d = n0 + (lane & 31);
    float tv[32];
#pragma unroll
    for (int i = 0; i < 32; ++i) tv[i] = f(k0 + 2 * i + (lane >> 5), d);
#pragma unroll
    for (int i = 0; i < 32; ++i) scr[(2 * i + (lane >> 5)) * 33 + (lane & 31)] = tv[i];
    LDS_WAIT(); asm volatile("" ::: "memory");
    const int c = lane & 7;
#pragma unroll
    for (int j = 0; j < 4; ++j) { const int n = (lane >> 3) + 8 * j; const LAS float* s = scr + (8 * c) * 33 + n;
        v4u o; o.x = pk2(s[0 * 33], s[1 * 33]); o.y = pk2(s[2 * 33], s[3 * 33]); o.z = pk2(s[4 * 33], s[5 * 33]); o.w = pk2(s[6 * 33], s[7 * 33]);
        *(GAS v4u*)(WT + (size_t)(n0 + n) * K + k0 + 8 * c) = o; }
    LDS_WAIT(); asm volatile("" ::: "memory");
}
struct FWin { const float* W; const float* g; DI float operator()(int k, int d) const {
    const int s = d < 512 ? d : (d < 2304 ? d + 8 : (d < 2312 ? d - 2304 + 512 : -1)); if (s < 0) return 0.f;
    const float v = W[(size_t)k * 2312 + s] * g[k]; return (d >= PC_Q && d < PC_K) ? v * (0.125f * 1.4426950408889634f) : v; } };
struct FPlain { const float* W; int ld; DI float operator()(int k, int d) const { return W[(size_t)k * ld + d]; } };
struct FGain { const float* W; int ld; const float* g; float mul; DI float operator()(int k, int d) const { return W[(size_t)k * ld + d] * g[k] * mul; } };
struct FRouter { const float* Wg; const float* We; const float* g; DI float operator()(int k, int d) const { const float v = d < 4 ? Wg[k * 4 + d] : (d < 36 ? We[k * 32 + d - 4] : 0.f); return v * g[k]; } };
struct FMl { const float* W; float mul; DI float operator()(int k, int d) const { return W[k * 64 + d] * mul; } };
struct FGU { const float* W; const float* g; DI float operator()(int k, int d) const { const int s = ((d >> 7) & 1) * 512 + (d >> 8) * 128 + (d & 127); return W[(size_t)k * 1024 + s] * g[k]; } };

DI void p0_prologue(Frame& F, const Args& A) {
    unsigned char* ws = A.ws;
    LAS float* scr = (LAS float*)(F.lds + RING_OFF + F.wave * 16384);
    const int gw = F.vcu * NWAVES + F.wave, NGW = F.G * NWAVES, lane = F.lane;
    constexpr int I_IN = 16 * 80, I_SQ = 16 * 32, I_KV = 16 * 64, I_RT = 16 * 2, I_GU = 32 * 512, I_DN = 32 * 256, I_ML = 24, I_GL = 32;
    constexpr int PER_L = I_IN + 3 * I_SQ + I_KV + I_RT + I_GU + I_DN + I_ML + I_GL;
    for (int it = gw; it < NLAYER * PER_L; it += NGW) {
        const int l = it / PER_L; int r = it % PER_L;
        if (r < I_IN) { FWin f{A.in[I_WIN] + (size_t)l * 1024 * 2312, A.in[I_NMIX] + l * 1024}; tr_item((bf16*)(ws + WS_WIN) + (size_t)l * 2560 * 1024, 1024, scr, r / 80, r % 80, lane, f); continue; } r -= I_IN;
        if (r < I_SQ) { FPlain f{A.in[I_WOUT] + (size_t)l * 1048576, 1024}; tr_item((bf16*)(ws + WS_WOUT) + (size_t)l * 1048576, 1024, scr, r / 32, r % 32, lane, f); continue; } r -= I_SQ;
        if (r < I_SQ) { FGain f{A.in[I_XWQ] + (size_t)l * 1048576, 1024, A.in[I_NXATTN] + l * 1024, 0.0625f}; tr_item((bf16*)(ws + WS_WQ) + (size_t)l * 1048576, 1024, scr, r / 32, r % 32, lane, f); continue; } r -= I_SQ;
        if (r < I_SQ) { FPlain f{A.in[I_XWO] + (size_t)l * 1048576, 1024}; tr_item((bf16*)(ws + WS_WO) + (size_t)l * 1048576, 1024, scr, r / 32, r % 32, lane, f); continue; } r -= I_SQ;
        if (r < I_KV) { FGain f{A.in[I_XWKV] + (size_t)l * 2097152, 2048, A.in[I_NMEM] + l * 1024, 1.0f}; tr_item((bf16*)(ws + WS_WKV) + (size_t)l * 2097152, 1024, scr, r / 64, r % 64, lane, f); continue; } r -= I_KV;
        if (r < I_RT) { FRouter f{A.in[I_RWG] + l * 4096, A.in[I_RWE] + l * 32768, A.in[I_NFFN] + l * 1024}; tr_item((bf16*)(ws + WS_WR) + (size_t)l * 65536, 1024, scr, r / 2, r % 2, lane, f); continue; } r -= I_RT;
        if (r < I_GU) { const int e = r / 512, q = r % 512; FGU f{A.in[I_EWGU] + ((size_t)l * 32 + e) * 1048576, A.in[I_NFFN] + l * 1024};
            tr_item((bf16*)(ws + WS_WGU) + ((size_t)l * 32 + e) * 1048576, 1024, scr, q / 32, q % 32, lane, f); continue; } r -= I_GU;
        if (r < I_DN) { const int e = r / 256, q = r % 256; FPlain f{A.in[I_EWDN] + ((size_t)l * 32 + e) * 524288, 1024};
            tr_item((bf16*)(ws + WS_WDN) + ((size_t)l * 32 + e) * 524288, 512, scr, q / 32, q % 32, lane, f); continue; } r -= I_DN;
        if (r < I_ML) { const int h = r / 6, which = (r % 6) / 2, nb = r % 2;
            const float* src = A.in[which == 0 ? I_MWQ : (which == 1 ? I_MWK : I_MWV)] + ((size_t)l * 4 + h) * 4096;
            FMl fm{src, which == 0 ? 0.125f : 1.0f};
            tr_item((bf16*)(ws + WS_TAB + TAB_MLW) + (((size_t)l * 4 + h) * 3 + which) * 4096, 64, scr, 0, nb, lane, fm); continue; } r -= I_ML;
        { FPlain f{A.in[I_S5WGLU] + (size_t)l * 65536, 256}; tr_item((bf16*)(ws + WS_TAB + TAB_GLU) + (size_t)l * 65536, 256, scr, r / 8, r % 8, lane, f); }
    }
    for (int m = gw; m < T + 512; m += NGW) {
        const bool ismem = m >= T; const float* src = ismem ? A.in[I_MEM] + (size_t)(m - T) * D : A.in[I_X] + (size_t)m * D;
        const GAS f32x4* xr = (const GAS f32x4*)src + lane;
        f32x4 v[4]; float s = 0.f;
#pragma unroll
        for (int j = 0; j < 4; ++j) { v[j] = xr[64 * j]; s += (v[j].x * v[j].x + v[j].y * v[j].y) + (v[j].z * v[j].z + v[j].w * v[j].w); }
        const float rs = 1.0f / sqrtf(wave_sum(s, lane) * (1.0f / D) + RMS_EPS); const float mul = ismem ? rs : 1.0f;
        bf16* dst = ismem ? (bf16*)(ws + WS_AMEM) + (size_t)(m - T) * D : (bf16*)(ws + WS_X) + (size_t)m * D;
        GAS v2u* o8 = (GAS v2u*)dst + lane;
#pragma unroll
        for (int j = 0; j < 4; ++j) { v2u w; w.x = pk2(v[j].x * mul, v[j].y * mul); w.y = pk2(v[j].z * mul, v[j].w * mul); o8[64 * j] = w; }
        if (!ismem && lane == 0) ((float*)(ws + WS_RSA))[m] = rs;
    }
    const int gt = F.vcu * NWAVES * 64 + F.tid, NGT = F.G * NWAVES * 64;
    for (int i = gt; i < 3 * 8 * 132; i += NGT) { const int p = i / (8 * 132), h = (i / 132) % 8, off = i % 132; const int dist = off * (p == 0 ? 1 : (p == 1 ? 4 : 16));
        int bk = dist; if (dist >= 16) { bk = 16 + (int)(log((double)dist / 16.0) / log(2048.0 / 16.0) * 16.0); bk = bk < 31 ? bk : 31; }
        ((float*)(ws + WS_TAB + TAB_BIAS))[i] = A.in[I_REL][bk * 8 + h]; }
    for (int i = gt; i < 3 * 8 * 5 * 64 * 16; i += NGT) { const int ph = i / 5120, rem = i % 5120, j = rem / 1024, ln = (rem >> 4) & 63, ri = rem & 15; const int p = ph >> 3, h = ph & 7;
        const int off = 128 - 32 * j + (ln & 31) - crow(ri, ln >> 5); float v = -1.0e30f;
        if (off >= 0 && off <= 128) { const int dist = off * (p == 0 ? 1 : (p == 1 ? 4 : 16)); int bk = dist; if (dist >= 16) { bk = 16 + (int)(log((double)dist / 16.0) / log(2048.0 / 16.0) * 16.0); bk = bk < 31 ? bk : 31; }
            v = A.in[I_REL][bk * 8 + h] * 1.4426950408889634f; }
        ((float*)(ws + WS_TAB + TAB_IMG))[i] = v; }
    for (int i = gt; i < NLAYER * 16 * 64; i += NGT) {
        const int l = i / 1024, g = (i / 64) % 16, p = i % 64;
        const float are = A.in[I_S5ARE][i], aim = A.in[I_S5AIM][i], dt = expf(A.in[I_S5DT][l * 16 + g]);
        const float mag = expf(are * dt); const float abr = mag * cosf(aim * dt), abi = mag * sinf(aim * dt);
        float* ab = (float*)(ws + WS_TAB + TAB_S5AB) + (size_t)i * 6; ab[0] = abr; ab[1] = abi;
        float pr = abr, pi = abi;
#pragma unroll 1
        for (int k = 0; k < 6; ++k) { float nr = pr * pr; asm volatile("" : "+v"(nr)); nr = __builtin_fmaf(-pi, pi, nr); asm volatile("" : "+v"(nr)); float ni = 2.f * pr * pi; asm volatile("" : "+v"(ni)); pr = nr; pi = ni; if (k == 1) { ab[2] = pr; ab[3] = pi; } }
        ab[4] = pr; ab[5] = pi;
        const float den = are * are + aim * aim, xr = abr - 1.0f, yi = abi;
        float cre = xr * are; asm volatile("" : "+v"(cre)); cre = __builtin_fmaf(yi, aim, cre) / den; asm volatile("" : "+v"(cre)); float cim = yi * are; asm volatile("" : "+v"(cim)); cim = __builtin_fmaf(-xr, aim, cim) / den; asm volatile("" : "+v"(cim));
        bf16* bb = (bf16*)(ws + WS_TAB + TAB_S5BB) + ((size_t)(l * 16 + g) * 128) * 16; bf16* cc = (bf16*)(ws + WS_TAB + TAB_S5CC) + ((size_t)(l * 16 + g) * 16) * 128;
        for (int h = 0; h < 16; ++h) {
            const float bre = A.in[I_S5BRE][(size_t)i * 16 + h], bim = A.in[I_S5BIM][(size_t)i * 16 + h];
            float v0 = cre * bre; asm volatile("" : "+v"(v0)); v0 = __builtin_fmaf(-cim, bim, v0); asm volatile("" : "+v"(v0)); float v1 = cre * bim; asm volatile("" : "+v"(v1)); v1 = __builtin_fmaf(cim, bre, v1); asm volatile("" : "+v"(v1));
            bb[(size_t)p * 16 + h] = f2bf(v0); bb[(size_t)(64 + p) * 16 + h] = f2bf(v1);
            const size_t ci = ((size_t)(l * 16 + g) * 16 + h) * 64 + p;
            cc[(size_t)h * 128 + 2 * p] = f2bf(A.in[I_S5CRE][ci]); cc[(size_t)h * 128 + 2 * p + 1] = f2bf(-A.in[I_S5CIM][ci]);
        }
    }
}
constexpr int VST_PITCH = 144;
DI void dil_attn_task(const bf16* __restrict__ P, bf16* __restrict__ OPp, float* __restrict__ LSEp, const LAS float* img  , LAS unsigned char* vst, int dil, int b, int h, int r, int qt, int lane) {
    asm volatile("" : "+v"(lane));
    const int l31 = lane & 31, hh = lane >> 5;
    const int qi = 32 * qt + l31;
    const size_t rowb = (size_t)b * SEQ;
    const bf16* qp = P + (rowb + (size_t)qi * dil + r) * PW + PC_Q + h * 64 + 8 * hh;
    bf16x8 qf[4];
#pragma unroll
    for (int ks = 0; ks < 4; ++ks) qf[ks] = *(const bf16x8*)(qp + 16 * ks);
    bf16x8 kf[5][4]; v4u vv[5][4];
#pragma unroll
    for (int j = 0; j < 5; ++j) {
        const int kb = 32 * (qt - 4 + j); int ki = kb + l31; ki = ki < 0 ? 0 : ki;
        const bf16* kp = P + (rowb + (size_t)ki * dil + r) * PW + PC_K + h * 64 + 8 * hh;
#pragma unroll
        for (int ks = 0; ks < 4; ++ks) kf[j][ks] = *(const bf16x8*)(kp + 16 * ks);
    }
#pragma unroll
    for (int j = 0; j < 5; ++j) {
        const int kb = 32 * (qt - 4 + j);
#pragma unroll
        for (int k = 0; k < 4; ++k) { const int piece = lane + 64 * k, rr = piece >> 3, ch = piece & 7; int ki = kb + rr; ki = ki < 0 ? 0 : ki;
            vv[j][k] = *(const v4u*)(P + (rowb + (size_t)ki * dil + r) * PW + PC_V + h * 64 + ch * 8); }
    }
    f32x16 s[5];
    float m = -3.0e38f;
#pragma unroll
    for (int j = 0; j < 5; ++j) {
        const LAS f32x4* ip = (const LAS f32x4*)(img + (j * 64 + lane) * 16);
        const f32x4 c0 = ip[0], c1 = ip[1], c2 = ip[2], c3 = ip[3];
        f32x16 a = {c0[0], c0[1], c0[2], c0[3], c1[0], c1[1], c1[2], c1[3], c2[0], c2[1], c2[2], c2[3], c3[0], c3[1], c3[2], c3[3]};
#pragma unroll
        for (int ks = 0; ks < 4; ++ks) a = MFMA32(kf[j][ks], qf[ks], a);
        if (qt - 4 + j < 0) {
#pragma unroll
            for (int i = 0; i < 16; ++i) a[i] = -1.0e30f;
        }
#pragma unroll
        for (int i = 0; i < 16; ++i) m = fmaxf(m, a[i]);
        s[j] = a;
    }
    m = fmaxf(m, shx(m, 32, lane));
    float lsum = 0.f;
#pragma unroll
    for (int j = 0; j < 5; ++j)
#pragma unroll
        for (int i = 0; i < 16; ++i) { const float p = __builtin_amdgcn_exp2f(s[j][i] - m); s[j][i] = p; lsum += p; }
    lsum += shx(lsum, 32, lane);
    const float inv = 1.0f / lsum;
    if (hh == 0) LSEp[(rowb + (size_t)qi * dil + r) * 8 + h] = m + __log2f(lsum);
    f32x16 o[2];
#pragma unroll
    for (int nt = 0; nt < 2; ++nt) o[nt] = (f32x16){0.f, 0.f, 0.f, 0.f, 0.f, 0.f, 0.f, 0.f, 0.f, 0.f, 0.f, 0.f, 0.f, 0.f, 0.f, 0.f};
    const int i16 = lane & 15, q4 = i16 >> 2, p4 = i16 & 3, blk = (lane >> 4) & 1;
#pragma unroll
    for (int j = 0; j < 5; ++j) {
#pragma unroll
        for (int k = 0; k < 4; ++k) { const int piece = lane + 64 * k, rr = piece >> 3, ch = piece & 7; *(LAS v4u*)(vst + rr * VST_PITCH + ch * 16) = vv[j][k]; }
#pragma unroll
        for (int st = 0; st < 2; ++st) {
            bf16x8 af;
            { const f32x16& x = s[j]; af = st == 0 ? pack8(x[0] * inv, x[1] * inv, x[2] * inv, x[3] * inv, x[4] * inv, x[5] * inv, x[6] * inv, x[7] * inv)
                                                  : pack8(x[8] * inv, x[9] * inv, x[10] * inv, x[11] * inv, x[12] * inv, x[13] * inv, x[14] * inv, x[15] * inv); }
#pragma unroll
            for (int nt = 0; nt < 2; ++nt) {
                const LAS unsigned char* a0 = vst + (16 * st + 4 * hh + q4) * VST_PITCH + (32 * nt + 16 * blk + 4 * p4) * 2;
                const s16x4 lo = vtr(a0), hi = vtr(a0 + 8 * VST_PITCH);
                const bf16x8 bfr = (bf16x8){lo[0], lo[1], lo[2], lo[3], hi[0], hi[1], hi[2], hi[3]};
                o[nt] = MFMA32(af, bfr, o[nt]);
            }
        }
    }
#pragma unroll
    for (int i = 0; i < 16; ++i) { const int qq = 32 * qt + crow(i, hh); bf16* op = OPp + (rowb + (size_t)qq * dil + r) * 512 + h * 64 + l31;
        op[0] = f2bf(o[0][i]); op[32] = f2bf(o[1][i]); }
}

DI void mlstm_cu_frags(const bf16* __restrict__ P, const LAS float* cw  , size_t row0  , int tchunk0  , int h, int lane,
                       bf16x8 (&cf)[2][4], bf16x8 (&uf)[2][4]) {
    const int l31 = lane & 31, hh = lane >> 5;
#pragma unroll
    for (int tt = 0; tt < 2; ++tt)
#pragma unroll
        for (int ks = 0; ks < 4; ++ks) {
            const int tok = 32 * tt + l31, ch = h * 64 + 16 * ks + 8 * hh; const int pos = tchunk0 + tok;
            const bf16* up = P + (row0 + tok) * PW + PC_MU + ch;
            float acc[8];
            { const f32x4 b0 = *(const LAS f32x4*)(cw + 1024 + ch), b1 = *(const LAS f32x4*)(cw + 1024 + ch + 4); acc[0] = b0[0]; acc[1] = b0[1]; acc[2] = b0[2]; acc[3] = b0[3]; acc[4] = b1[0]; acc[5] = b1[1]; acc[6] = b1[2]; acc[7] = b1[3]; }
#pragma unroll
            for (int tap = 0; tap < 4; ++tap) {
                const int back = 3 - tap; const bool ok = pos - back >= 0;
                v4u w = *(const v4u*)(up - (ok ? (size_t)back * PW : 0));
                if (!ok) w = (v4u){0u, 0u, 0u, 0u};
                if (tap == 3) uf[tt][ks] = __builtin_bit_cast(bf16x8, w);
                float f[8]; unpack8(w, f);
                const f32x4 w0 = *(const LAS f32x4*)(cw + tap * 256 + ch), w1 = *(const LAS f32x4*)(cw + tap * 256 + ch + 4);
                acc[0] += w0[0] * f[0]; acc[1] += w0[1] * f[1]; acc[2] += w0[2] * f[2]; acc[3] += w0[3] * f[3]; acc[4] += w1[0] * f[4]; acc[5] += w1[1] * f[5]; acc[6] += w1[2] * f[6]; acc[7] += w1[3] * f[7];
            }
#pragma unroll
            for (int e = 0; e < 8; ++e) acc[e] = acc[e] * sigmoidf_(acc[e]);
            cf[tt][ks] = pack8(acc[0], acc[1], acc[2], acc[3], acc[4], acc[5], acc[6], acc[7]);
            asm volatile("" : "+v"(cf[tt][ks]), "+v"(uf[tt][ks]));
        }
}
DI float log_sigmoid_(float x) { const float e = __expf(-fabsf(x)); return fminf(x, 0.f) - __logf(1.0f + e); }
DI float wave_incl_scan(float v, int lane) {
#pragma unroll
    for (int o = 1; o < 64; o <<= 1) { const float t = shl_from(v, lane - o); if (lane >= o) v += t; }
    return v;
}
DI void mlstm_b1_task(const bf16* __restrict__ P, const float* __restrict__ G, const bf16* __restrict__ mlw  , const float* __restrict__ gb  ,
                      const LAS float* cw, LAS float* wsc  , float* __restrict__ MST, float* __restrict__ MSC, int b, int c, int h, int lane) {
    asm volatile("" : "+v"(lane));
    const int l31 = lane & 31, hh = lane >> 5;
    const size_t row0 = (size_t)b * SEQ + (size_t)c * 64;
    bf16x8 cf[2][4], uf[2][4];
    mlstm_cu_frags(P, cw, row0, c * 64, h, lane, cf, uf);
    const float li = G[(row0 + lane) * 8 + h] + gb[h];
    const float lf = log_sigmoid_(G[(row0 + lane) * 8 + 4 + h] + gb[4 + h]);
    const float bcs = wave_incl_scan(lf, lane);
    const float gtot = __builtin_bit_cast(float, __builtin_amdgcn_readlane(__builtin_bit_cast(int, bcs), 63));
    const float a = gtot - bcs + li;
    const float amax = wave_max(a, lane);
    wsc[lane] = __expf(a - amax);
    LDS_WAIT();
    const bf16* wk = mlw + ((size_t)h * 3 + 1) * 4096, * wv = mlw + ((size_t)h * 3 + 2) * 4096;
    const f32x16 z16 = {0.f, 0.f, 0.f, 0.f, 0.f, 0.f, 0.f, 0.f, 0.f, 0.f, 0.f, 0.f, 0.f, 0.f, 0.f, 0.f};
    float* st = MST + ((size_t)(b * 4 + h) * 256 + c) * 4160;
    bf16x8 kpk[2][2][2];
    {
        f32x16 kacc[2][2] = {{z16, z16}, {z16, z16}};
#pragma unroll
        for (int ks = 0; ks < 4; ++ks)
#pragma unroll
            for (int nt = 0; nt < 2; ++nt) { const bf16x8 bk = *(const bf16x8*)(wk + (32 * nt + l31) * 64 + 16 * ks + 8 * hh);
#pragma unroll
                for (int tt = 0; tt < 2; ++tt) kacc[tt][nt] = MFMA32(cf[tt][ks], bk, kacc[tt][nt]); }
        float nsum[2] = {0.f, 0.f};
#pragma unroll
        for (int tt = 0; tt < 2; ++tt)
#pragma unroll
            for (int i = 0; i < 16; ++i) { const float w = wsc[32 * tt + crow(i, hh)];
#pragma unroll
                for (int nt = 0; nt < 2; ++nt) { kacc[tt][nt][i] *= w; nsum[nt] += kacc[tt][nt][i]; } }
#pragma unroll
        for (int nt = 0; nt < 2; ++nt) { nsum[nt] += shx(nsum[nt], 32, lane); if (hh == 0) st[4096 + 32 * nt + l31] = nsum[nt]; }
#pragma unroll
        for (int tt = 0; tt < 2; ++tt)
#pragma unroll
            for (int nt = 0; nt < 2; ++nt) { kpk[tt][nt][0] = packstep(kacc[tt][nt], 0); kpk[tt][nt][1] = packstep(kacc[tt][nt], 1); }
    }
    __builtin_amdgcn_sched_barrier(0);
#pragma unroll
    for (int et = 0; et < 2; ++et) {
        f32x16 va[2] = {z16, z16};
#pragma unroll
        for (int ks = 0; ks < 4; ++ks) { const bf16x8 bv = *(const bf16x8*)(wv + (32 * et + l31) * 64 + 16 * ks + 8 * hh);
#pragma unroll
            for (int tt = 0; tt < 2; ++tt) va[tt] = MFMA32(uf[tt][ks], bv, va[tt]); }
        const bf16x8 v00 = packstep(va[0], 0), v01 = packstep(va[0], 1), v10 = packstep(va[1], 0), v11 = packstep(va[1], 1);
#pragma unroll
        for (int dt = 0; dt < 2; ++dt) {
            f32x16 u = z16;
            u = MFMA32(v00, kpk[0][dt][0], u); u = MFMA32(v01, kpk[0][dt][1], u); u = MFMA32(v10, kpk[1][dt][0], u); u = MFMA32(v11, kpk[1][dt][1], u);
#pragma unroll
            for (int i = 0; i < 16; ++i) st[(32 * et + crow(i, hh)) * 64 + 32 * dt + l31] = u[i];
        }
        __builtin_amdgcn_sched_barrier(0);
    }
    if (lane == 0) { MSC[((size_t)(b * 4 + h) * 256 + c) * 2] = gtot; MSC[((size_t)(b * 4 + h) * 256 + c) * 2 + 1] = amax; }
}

#define CSTEP(nr, ni, ar_, ai_, xr_, xi_, br_, bi_) do { nr = __builtin_fmaf((ar_), (xr_), (br_)); asm volatile("" : "+v"(nr)); nr = __builtin_fmaf(-(ai_), (xi_), nr); asm volatile("" : "+v"(nr)); \
    ni = __builtin_fmaf((ar_), (xi_), (bi_)); asm volatile("" : "+v"(ni)); ni = __builtin_fmaf((ai_), (xr_), ni); asm volatile("" : "+v"(ni)); } while (0)
DI void s5_bu(const bf16* __restrict__ P, const bf16* __restrict__ bb  , size_t row0, int g, int lane, f32x16 (&acc)[2][4]) {
    const int l31 = lane & 31, hh = lane >> 5;
    bf16x8 af[2], bfr[4];
#pragma unroll
    for (int tt = 0; tt < 2; ++tt) af[tt] = *(const bf16x8*)(P + (row0 + 32 * tt + l31) * PW + PC_SU + g * 16 + 8 * hh);
#pragma unroll
    for (int nt = 0; nt < 4; ++nt) bfr[nt] = *(const bf16x8*)(bb + (32 * nt + l31) * 16 + 8 * hh);
#pragma unroll
    for (int tt = 0; tt < 2; ++tt)
#pragma unroll
        for (int nt = 0; nt < 4; ++nt) acc[tt][nt] = MFMA32(af[tt], bfr[nt], ((f32x16){0.f, 0.f, 0.f, 0.f, 0.f, 0.f, 0.f, 0.f, 0.f, 0.f, 0.f, 0.f, 0.f, 0.f, 0.f, 0.f}));
}
DI void s5_end_task(const bf16* __restrict__ P, const bf16* __restrict__ bb, const float* __restrict__ ab  , float* __restrict__ S5ST, int b, int c, int g, int lane) {
    asm volatile("" : "+v"(lane));
    const int l31 = lane & 31, hh = lane >> 5;
    const size_t row0 = (size_t)b * SEQ + (size_t)c * 64;
    f32x16 acc[2][4];
    s5_bu(P, bb, row0, g, lane, acc);
#pragma unroll
    for (int pt = 0; pt < 2; ++pt) {
        const float* abp = ab + (32 * pt + l31) * 6; const float ar = abp[0], ai = abp[1], a4r = abp[2], a4i = abp[3];
        const float prr = hh ? a4r : 1.f, pri = hh ? a4i : 0.f, por = hh ? 1.f : a4r, poi = hh ? 0.f : a4i;
        float xr = 0.f, xi = 0.f;
#pragma unroll
        for (int tt = 0; tt < 2; ++tt)
#pragma unroll
            for (int q4 = 0; q4 < 4; ++q4) {
                { float nr, ni; CSTEP(nr, ni, prr, pri, xr, xi, 0.f, 0.f); xr = nr; xi = ni; }
#pragma unroll
                for (int j = 0; j < 4; ++j) { float nr, ni; CSTEP(nr, ni, ar, ai, xr, xi, acc[tt][pt][4 * q4 + j], acc[tt][2 + pt][4 * q4 + j]); xr = nr; xi = ni; }
                { float nr, ni; CSTEP(nr, ni, por, poi, xr, xi, 0.f, 0.f); xr = nr; xi = ni; }
            }
        xr += shx(xr, 32, lane); xi += shx(xi, 32, lane);
        if (DBG_S5_SYNTH) { xr = 0.01f * (float)((c + l31 + g) & 15); xi = -0.005f * (float)((c + pt) & 7); }
        if (hh == 0) { f32x2 v = {xr, xi}; *(f32x2*)(S5ST + ((((size_t)b * 256 + c) * 16 + g) * 64 + 32 * pt + l31) * 2) = v; }
    }
}
DI void mlstm_scan_task(float* __restrict__ MST, const float* __restrict__ MSC, float* __restrict__ MPREV, int wt  , int lane) {
    asm volatile("" : "+v"(lane));
    const int e = wt * 64 + lane; const int bh = e / 4160, el = e % 4160;
    float* st = MST + (size_t)bh * 256 * 4160 + el; const float* sc = MSC + (size_t)bh * 512;
    float m = 0.f, C = 0.f;
#pragma unroll 1
    for (int c0 = 0; c0 < 256; c0 += 16) {
        float u[16];
#pragma unroll
        for (int k = 0; k < 16; ++k) u[k] = st[(size_t)(c0 + k) * 4160];
#pragma unroll
        for (int k = 0; k < 16; ++k) {
            const float g = sc[(c0 + k) * 2], amax = sc[(c0 + k) * 2 + 1];
            const float mn = fmaxf(g + m, amax); const float dec = __expf(g + m - mn), scl = __expf(amax - mn);
            st[(size_t)(c0 + k) * 4160] = C; if (el == 0) MPREV[bh * 256 + c0 + k] = m;
            C = dec * C + scl * u[k]; m = mn;
        }
    }
}
DI void s5_scan_task(float* __restrict__ S5ST, const float* __restrict__ ab  , int wt  , int lane) {
    asm volatile("" : "+v"(lane));
    const int e = wt * 64 + lane; const int b = e >> 10, gp = e & 1023;
    const float a64r = ab[gp * 6 + 4], a64i = ab[gp * 6 + 5];
    float* st = S5ST + ((size_t)b * 256 * 1024 + gp) * 2;
    float xr = 0.f, xi = 0.f;
#pragma unroll 1
    for (int c0 = 0; c0 < 256; c0 += 16) {
        f32x2 u[16];
#pragma unroll
        for (int k = 0; k < 16; ++k) u[k] = *(const f32x2*)(st + (size_t)(c0 + k) * 2048);
#pragma unroll
        for (int k = 0; k < 16; ++k) { f32x2 o = {xr, xi}; *(f32x2*)(st + (size_t)(c0 + k) * 2048) = o;
            float nr, ni; CSTEP(nr, ni, a64r, a64i, xr, xi, u[k].x, u[k].y); xr = nr; xi = ni; }
    }
}

DI void mlstm_b3_task(const bf16* __restrict__ P, const float* __restrict__ G, const bf16* __restrict__ mlw, const float* __restrict__ gb, const float* __restrict__ mnorm  , const float* __restrict__ mskip  ,
                      const LAS float* cw, LAS float* wsc  , LAS unsigned char* hst  , const float* __restrict__ MST, const float* __restrict__ MPREV,
                      bf16* __restrict__ Y, int b, int c, int h, int lane) {
    asm volatile("" : "+v"(lane));
    const int l31 = lane & 31, hh = lane >> 5;
    const size_t row0 = (size_t)b * SEQ + (size_t)c * 64;
    bf16x8 cf[2][4], uf[2][4];
    mlstm_cu_frags(P, cw, row0, c * 64, h, lane, cf, uf);
    const float li = G[(row0 + lane) * 8 + h] + gb[h];
    const float lf = log_sigmoid_(G[(row0 + lane) * 8 + 4 + h] + gb[4 + h]);
    const float bcs = wave_incl_scan(lf, lane);
    const float mprev = MPREV[(b * 4 + h) * 256 + c];
    const float* st = MST + ((size_t)(b * 4 + h) * 256 + c) * 4160;
    wsc[lane] = bcs; wsc[64 + lane] = li - bcs; wsc[128 + lane] = st[4096 + lane];
    LDS_WAIT();
    float bl[2], mt[2], inter[2];
#pragma unroll
    for (int lt = 0; lt < 2; ++lt) {
        const int l = 32 * lt + l31; bl[lt] = wsc[l]; float mx = -3.0e38f;
#pragma unroll 8
        for (int s = 0; s < 64; ++s) { const float v = wsc[64 + s]; mx = (s <= l) ? fmaxf(mx, v) : mx; }
        const float mi = bl[lt] + mprev; mt[lt] = fmaxf(mi, bl[lt] + mx); inter[lt] = __expf(mi - mt[lt]);
    }
    const bf16* wq = mlw + ((size_t)h * 3 + 0) * 4096, * wk = mlw + ((size_t)h * 3 + 1) * 4096, * wv = mlw + ((size_t)h * 3 + 2) * 4096;
    const f32x16 z16 = {0.f, 0.f, 0.f, 0.f, 0.f, 0.f, 0.f, 0.f, 0.f, 0.f, 0.f, 0.f, 0.f, 0.f, 0.f, 0.f};
    __builtin_amdgcn_sched_barrier(0);
#pragma unroll
    for (int lt = 0; lt < 2; ++lt) {
        const int l = 32 * lt + l31;
        asm volatile("" ::: "memory");
        bf16x8 qp[2][2], qsp[2][2]; float dq = 0.f;
#pragma unroll
        for (int dt = 0; dt < 2; ++dt) {
            f32x16 qa = z16;
#pragma unroll
            for (int ks = 0; ks < 4; ++ks) { const bf16x8 aq = *(const bf16x8*)(wq + (32 * dt + l31) * 64 + 16 * ks + 8 * hh); qa = MFMA32(aq, cf[lt][ks], qa); }
            qp[dt][0] = packstep(qa, 0); qp[dt][1] = packstep(qa, 1);
            f32x16 qs = qa * inter[lt];
#pragma unroll
            for (int i = 0; i < 16; ++i) dq += qs[i] * wsc[128 + 32 * dt + crow(i, hh)];
            qsp[dt][0] = packstep(qs, 0); qsp[dt][1] = packstep(qs, 1);
            asm volatile("" : "+v"(qp[dt][0]), "+v"(qp[dt][1]), "+v"(qsp[dt][0]), "+v"(qsp[dt][1]), "+v"(dq));
        }
        asm volatile("" ::: "memory");
        f32x16 oacc[2] = {z16, z16};
#pragma unroll
        for (int et = 0; et < 2; ++et)
#pragma unroll
            for (int dt = 0; dt < 2; ++dt)
#pragma unroll
                for (int sp = 0; sp < 2; ++sp) {
                    const float* cp = st + (size_t)(32 * et + l31) * 64 + 32 * dt + 16 * sp + 4 * hh;
                    const f32x4 c0 = *(const f32x4*)cp, c1 = *(const f32x4*)(cp + 8);
                    oacc[et] = MFMA32(pack8(c0[0], c0[1], c0[2], c0[3], c1[0], c1[1], c1[2], c1[3]), qsp[dt][sp], oacc[et]);
                }
        asm volatile("" : "+v"(oacc[0]), "+v"(oacc[1]) :: "memory");
        float rsum = 0.f;
#pragma unroll
        for (int stl = 0; stl < 2; ++stl) {
            if (stl > lt) continue;
            asm volatile("" ::: "memory");
            f32x16 sacc = z16;
#pragma unroll
            for (int dt = 0; dt < 2; ++dt) {
                f32x16 ka = z16;
#pragma unroll
                for (int ks = 0; ks < 4; ++ks) { const bf16x8 ak = *(const bf16x8*)(wk + (32 * dt + l31) * 64 + 16 * ks + 8 * hh); ka = MFMA32(ak, cf[stl][ks], ka); }
                sacc = MFMA32(packstep(ka, 0), qp[dt][0], sacc); sacc = MFMA32(packstep(ka, 1), qp[dt][1], sacc);
            }
#pragma unroll
            for (int i = 0; i < 16; ++i) { const int s = 32 * stl + crow(i, hh); const float dm = bl[lt] + wsc[64 + s] - mt[lt];
                const float w = (s <= l) ? __expf(dm) * sacc[i] : 0.f; sacc[i] = w; rsum += w; }
            bf16x8 w0 = packstep(sacc, 0), w1 = packstep(sacc, 1);
            asm volatile("" : "+v"(w0), "+v"(w1), "+v"(rsum) :: "memory");
#pragma unroll
            for (int et = 0; et < 2; ++et) {
                f32x16 va = z16;
#pragma unroll
                for (int ks = 0; ks < 4; ++ks) { const bf16x8 bv = *(const bf16x8*)(wv + (32 * et + l31) * 64 + 16 * ks + 8 * hh);
                    const bf16x8 ua = *(const bf16x8*)(P + (row0 + 32 * stl + l31) * PW + PC_MU + h * 64 + 16 * ks + 8 * hh); va = MFMA32(ua, bv, va); }
                oacc[et] = MFMA32(packstep(va, 0), w0, oacc[et]); oacc[et] = MFMA32(packstep(va, 1), w1, oacc[et]);
                asm volatile("" ::: "memory");
            }
        }
        float den = dq + rsum; den += shx(den, 32, lane);
        const float dn = fmaxf(fabsf(den), __expf(-mt[lt])); const float rd = 1.0f / dn;
        float ss = 0.f;
#pragma unroll
        for (int et = 0; et < 2; ++et)
#pragma unroll
            for (int i = 0; i < 16; ++i) { const float hv = oacc[et][i] * rd; oacc[et][i] = hv; ss += hv * hv; }
        ss += shx(ss, 32, lane);
        const float rn = 1.0f / sqrtf(ss * (1.0f / 64.0f) + RMS_EPS);
#pragma unroll
        for (int et = 0; et < 2; ++et)
#pragma unroll
            for (int g4 = 0; g4 < 4; ++g4) { v2u w; w.x = pk2(oacc[et][4 * g4] * rn, oacc[et][4 * g4 + 1] * rn); w.y = pk2(oacc[et][4 * g4 + 2] * rn, oacc[et][4 * g4 + 3] * rn);
                *(LAS v2u*)(hst + l * 144 + (32 * et + 8 * g4 + 4 * hh) * 2) = w; }
        LDS_WAIT();
        {
            const int tt = lt;
#pragma unroll
            for (int ks = 0; ks < 4; ++ks) {
                const int tok = 32 * tt + l31, chh = 16 * ks + 8 * hh, ch = h * 64 + chh;
                const v4u hw = *(const LAS v4u*)(hst + tok * 144 + chh * 2); const v4u ow = *(const v4u*)(P + (row0 + tok) * PW + PC_MO + ch); const v4u cwv = __builtin_bit_cast(v4u, cf[tt][ks]);
                float hv[8], ov[8], cv[8]; unpack8(hw, hv); unpack8(ow, ov); unpack8(cwv, cv);
                const f32x4 g0 = *(const f32x4*)(mnorm + ch), g1 = *(const f32x4*)(mnorm + ch + 4), k0 = *(const f32x4*)(mskip + ch), k1 = *(const f32x4*)(mskip + ch + 4);
                float r[8];
#pragma unroll
                for (int e = 0; e < 8; ++e) { const float gn = e < 4 ? g0[e & 3] : g1[e & 3], sk = e < 4 ? k0[e & 3] : k1[e & 3]; r[e] = sigmoidf_(ov[e]) * (hv[e] * gn + sk * cv[e]); }
                v4u o; o.x = pk2(r[0], r[1]); o.y = pk2(r[2], r[3]); o.z = pk2(r[4], r[5]); o.w = pk2(r[6], r[7]);
                *(v4u*)(Y + (row0 + tok) * 1024 + ch) = o;
            }
        }
        __builtin_amdgcn_sched_barrier(0);
    }
}

DI float gelu_tanh_(float x) { const float u = 0.7978845608028654f * (x + 0.044715f * x * x * x); const float t = 1.0f - 2.0f / (1.0f + __expf(2.0f * u)); return 0.5f * x * (1.0f + t); }

constexpr int XS_PITCH = 272, ZT_PITCH = 528;
constexpr int S5L_XS = 0, S5L_Z = 8 * 32 * XS_PITCH, S5L_OUT = 0, S5L_END = S5L_Z + 64 * ZT_PITCH;
static_assert(S5L_END <= RING_BYTES, "S5 LDS map");
DI void s5_out_unit(Frame& F, int tid_p, const bf16* __restrict__ P, const bf16* __restrict__ bbL  , const bf16* __restrict__ ccL  , const float* __restrict__ abL  ,
                    const float* __restrict__ dskip  , const bf16* __restrict__ gluT  , const float* __restrict__ bglu, const float* __restrict__ onorm, const float* __restrict__ S5ST,
                    bf16* __restrict__ Y, int b, int c, unsigned* dbg_chk = nullptr) {
    const int lane = tid_p & 63, wave = __builtin_amdgcn_readfirstlane(tid_p >> 6), l31 = lane & 31, hh = lane >> 5, l15 = lane & 15, lq = lane >> 4;
    const size_t row0 = (size_t)b * SEQ + (size_t)c * 64;
    LAS unsigned char* xs = F.lds + S5L_XS + wave * 32 * XS_PITCH; LAS unsigned char* zt = F.lds + S5L_Z; LAS unsigned char* ot = F.lds + S5L_OUT;
#if DBG_S5_LDSFILL
    for (int i = tid_p; i < S5L_END / 4; i += 512) ((LAS unsigned*)F.lds)[i] = 0u;
    __syncthreads();
#endif
    unsigned hW = 0u, hR = 0u, hY = 0u, hB = 0u;
#pragma unroll 1
    for (int gi = 0; gi < 2; ++gi) {
        const int g = wave * 2 + gi;
        float cr[2], ci[2], ar[2], ai[2];
#pragma unroll
        for (int pt = 0; pt < 2; ++pt) { const float* abp = abL + ((size_t)g * 64 + 32 * pt + l31) * 6; ar[pt] = abp[0]; ai[pt] = abp[1];
            const f32x2 cin = *(const f32x2*)(S5ST + ((((size_t)b * 256 + c) * 16 + g) * 64 + 32 * pt + l31) * 2); cr[pt] = DBG_S5_NOCARRY ? 0.f : cin.x; ci[pt] = DBG_S5_NOCARRY ? 0.f : cin.y;
            hB = hB * 31u + __float_as_uint(cin.x) + 3u * __float_as_uint(cin.y); hR = hR * 31u + __float_as_uint(ar[pt]) + 3u * __float_as_uint(ai[pt]);
            if (DBG_S5_SYNTH == 2) { cr[pt] = 0.01f * (float)((c + l31 + g) & 15); ci[pt] = -0.005f * (float)((c + pt) & 7); } }
        bf16x8 cfr[4];
#pragma unroll
        for (int ks = 0; ks < 4; ++ks) cfr[ks] = *(const bf16x8*)(ccL + ((size_t)g * 16 + l15) * 128 + 32 * ks + 8 * lq);
        const bf16* bbg = bbL + (size_t)g * 2048;
#pragma unroll
        for (int tt = 0; tt < 2; ++tt) {
            const bf16x8 uaf = *(const bf16x8*)(P + (row0 + 32 * tt + l31) * PW + PC_SU + g * 16 + 8 * hh);
#pragma unroll
            for (int pt = 0; pt < 2; ++pt) {
                const f32x16 z16 = {0.f, 0.f, 0.f, 0.f, 0.f, 0.f, 0.f, 0.f, 0.f, 0.f, 0.f, 0.f, 0.f, 0.f, 0.f, 0.f};
                f32x16 bre = MFMA32(uaf, *(const bf16x8*)(bbg + (32 * pt + l31) * 16 + 8 * hh), z16); f32x16 bim_ = MFMA32(uaf, *(const bf16x8*)(bbg + (64 + 32 * pt + l31) * 16 + 8 * hh), z16);
                asm volatile("s_nop 15\n\ts_nop 15\n\ts_nop 15\n\ts_nop 15" : "+v"(bre), "+v"(bim_) :: "memory"); const f32x16 bim = bim_;
#if DBG_S5_TWICE
                for (int i_ = 0; i_ < 16; ++i_) hY = hY * 31u + __float_as_uint(bre[i_]) + 7u * __float_as_uint(bim[i_]);
#endif
#pragma unroll
                for (int q4 = 0; q4 < 4; ++q4) {
                    float y0r[4], y0i[4], y1r[4], y1i[4];
                    float xr = cr[pt], xi = ci[pt];
#if DBG_S5_TWICE
                    hR = hR * 31u + __float_as_uint(xr) + 3u * __float_as_uint(xi) + 5u * __float_as_uint(ar[pt]) + 7u * __float_as_uint(ai[pt]);
                    for (int j_ = 0; j_ < 4; ++j_) hR = hR * 31u + __float_as_uint(bre[4 * q4 + j_]) + 3u * __float_as_uint(bim[4 * q4 + j_]);
#endif
#pragma unroll
                    for (int j = 0; j < 4; ++j) { float nr, ni; CSTEP(nr, ni, ar[pt], ai[pt], xr, xi, bre[4 * q4 + j], bim[4 * q4 + j]); xr = nr; xi = ni; y0r[j] = nr; y0i[j] = ni; }
#if DBG_S5_TWICE
                    for (int j_ = 0; j_ < 4; ++j_) hB = hB * 31u + __float_as_uint(y0r[j_]) + 3u * __float_as_uint(y0i[j_]);
#endif
                    if (!DBG_S5_NOPERM) { xr = shl_from(xr, l31); xi = shl_from(xi, l31); }
#pragma unroll
                    for (int j = 0; j < 4; ++j) { float nr, ni; CSTEP(nr, ni, ar[pt], ai[pt], xr, xi, bre[4 * q4 + j], bim[4 * q4 + j]); xr = nr; xi = ni; y1r[j] = nr; y1i[j] = ni; }
                    if (!DBG_S5_NOPERM) { cr[pt] = shl_from(xr, 32 + l31); ci[pt] = shl_from(xi, 32 + l31); }
#pragma unroll
                    for (int j = 0; j < 4; ++j) { const int tok = 8 * q4 + 4 * hh + j; const float vr = hh ? y1r[j] : y0r[j], vi = hh ? y1i[j] : y0i[j];
                        const unsigned pw_ = pk2(vr, vi); hW = hW * 31u + pw_; *(LAS unsigned*)(xs + tok * XS_PITCH + (32 * pt + l31) * 4) = pw_; }
                }
                asm volatile("" : "+v"(cr[pt]), "+v"(ci[pt]));
            }
            LDS_WAIT();
#pragma unroll
            for (int mt = 0; mt < 2; ++mt) {
                f32x4 ya = {0.f, 0.f, 0.f, 0.f};
#pragma unroll
                for (int ks = 0; ks < 4; ++ks) { const bf16x8 xf = *(const LAS bf16x8*)(xs + (16 * mt + l15) * XS_PITCH + (32 * ks + 8 * lq) * 2); ya = MFMA16(cfr[ks], xf, ya); }
                const int tok = 32 * tt + 16 * mt + l15;
                const f32x4 dsk = *(const f32x4*)(dskip + g * 16 + 4 * lq); const v2u uw = *(const v2u*)(P + (row0 + tok) * PW + PC_SU + g * 16 + 4 * lq);
                v2u zw; zw.x = pk2(gelu_tanh_(ya[0] + dsk[0] * bflo(uw.x)), gelu_tanh_(ya[1] + dsk[1] * bfhi(uw.x))); zw.y = pk2(gelu_tanh_(ya[2] + dsk[2] * bflo(uw.y)), gelu_tanh_(ya[3] + dsk[3] * bfhi(uw.y)));
                *(LAS v2u*)(zt + tok * ZT_PITCH + (g * 16 + 4 * lq) * 2) = zw;
            }
            LDS_WAIT();
        }
    }
    __syncthreads();
#if DBG_S5_TWICE
    if (dbg_chk) { dbg_chk[512 + tid_p] = hW; dbg_chk[1024 + tid_p] = hR; dbg_chk[1536 + tid_p] = hY; dbg_chk[2048 + tid_p] = hB; }
    if (dbg_chk) { unsigned x = 0u; for (int i = tid_p; i < 64 * 128; i += 512) { const int r = i >> 7, cdw = i & 127; x ^= *(const LAS unsigned*)(zt + r * ZT_PITCH + cdw * 4) * (unsigned)(i * 2654435761u + 1u); } dbg_chk[tid_p] = x; }
#endif
    {
        const f32x16 z16 = {0.f, 0.f, 0.f, 0.f, 0.f, 0.f, 0.f, 0.f, 0.f, 0.f, 0.f, 0.f, 0.f, 0.f, 0.f, 0.f};
        f32x16 ga[2] = {z16, z16}; const int nrow = 32 * wave + l31;
#pragma unroll 4
        for (int ks = 0; ks < 16; ++ks) { const bf16x8 wfr = *(const bf16x8*)(gluT + (size_t)nrow * 256 + 16 * ks + 8 * hh);
#pragma unroll
            for (int tt = 0; tt < 2; ++tt) { const bf16x8 zf = *(const LAS bf16x8*)(zt + (32 * tt + l31) * ZT_PITCH + (16 * ks + 8 * hh) * 2); ga[tt] = MFMA32(wfr, zf, ga[tt]); } }
#pragma unroll
        for (int tt = 0; tt < 2; ++tt) { const int tok = 32 * tt + l31;
#pragma unroll
            for (int q = 0; q < 4; ++q) { const int n0 = 32 * wave + 8 * q + 4 * hh; const f32x4 bg = *(const f32x4*)(bglu + n0); const v2u zw = *(const LAS v2u*)(zt + tok * ZT_PITCH + n0 * 2);
                v2u ow; ow.x = pk2(bflo(zw.x) * sigmoidf_(ga[tt][4 * q] + bg[0]), bfhi(zw.x) * sigmoidf_(ga[tt][4 * q + 1] + bg[1])); ow.y = pk2(bflo(zw.y) * sigmoidf_(ga[tt][4 * q + 2] + bg[2]), bfhi(zw.y) * sigmoidf_(ga[tt][4 * q + 3] + bg[3]));
                *(LAS v2u*)(ot + tok * 512 + n0 * 2) = ow; } }
    }
    __syncthreads();
#pragma unroll 1
    for (int k = 0; k < 8; ++k) { const int tok = wave * 8 + k; const v2u w = *(const LAS v2u*)(ot + tok * 512 + lane * 8);
        const float a0 = bflo(w.x), a1 = bfhi(w.x), a2 = bflo(w.y), a3 = bfhi(w.y);
        const float rn = 1.0f / sqrtf(wave_sum((a0 * a0 + a1 * a1) + (a2 * a2 + a3 * a3), lane) * (1.0f / 256.0f) + RMS_EPS);
        const f32x4 gn = *(const f32x4*)(onorm + lane * 4); v2u o; o.x = pk2(a0 * rn * gn[0], a1 * rn * gn[1]); o.y = pk2(a2 * rn * gn[2], a3 * rn * gn[3]);
        *(v2u*)(Y + (row0 + tok) * 1024 + 256 + lane * 4) = o; }
    __syncthreads();
}
DI void attn_merge_row(const bf16* __restrict__ OP, const float* __restrict__ LSE, const float* __restrict__ anorm, bf16* __restrict__ Y, size_t row, int lane) {
    asm volatile("" : "+v"(lane));
    const int h = lane >> 3;
    const float l0 = LSE[row * 8 + h], l1 = LSE[((size_t)T + row) * 8 + h], l2 = LSE[((size_t)2 * T + row) * 8 + h];
    const float mx = fmaxf(l0, fmaxf(l1, l2)); const float e0 = __builtin_amdgcn_exp2f(l0 - mx), e1 = __builtin_amdgcn_exp2f(l1 - mx), e2 = __builtin_amdgcn_exp2f(l2 - mx); const float rsum = 1.0f / (e0 + e1 + e2);
    const v4u a = *(const v4u*)(OP + row * 512 + lane * 8), bq = *(const v4u*)(OP + ((size_t)T + row) * 512 + lane * 8), cq = *(const v4u*)(OP + ((size_t)2 * T + row) * 512 + lane * 8);
    float fa[8], fb[8], fc[8], r[8]; unpack8(a, fa); unpack8(bq, fb); unpack8(cq, fc); float ss = 0.f;
#pragma unroll
    for (int e = 0; e < 8; ++e) { r[e] = (e0 * fa[e] + e1 * fb[e] + e2 * fc[e]) * rsum; ss += r[e] * r[e]; }
    const float rn = 1.0f / sqrtf(wave_sum(ss, lane) * (1.0f / 512.0f) + RMS_EPS);
    const f32x4 g0 = *(const f32x4*)(anorm + lane * 8), g1 = *(const f32x4*)(anorm + lane * 8 + 4);
    v4u o; o.x = pk2(r[0] * rn * g0[0], r[1] * rn * g0[1]); o.y = pk2(r[2] * rn * g0[2], r[3] * rn * g0[3]); o.z = pk2(r[4] * rn * g1[0], r[5] * rn * g1[1]); o.w = pk2(r[6] * rn * g1[2], r[7] * rn * g1[3]);
    *(v4u*)(Y + row * 1024 + 512 + lane * 8) = o;
}
DI void xattn_task(const bf16* __restrict__ Q, const bf16* __restrict__ Km  , const bf16* __restrict__ Vt  , bf16* __restrict__ OX, int b, int hd, int qt, int lane) {
    asm volatile("" : "+v"(lane));
    const int l31 = lane & 31, hh = lane >> 5;
    const size_t qrow = (size_t)b * SEQ + 32 * qt + l31;
    const f32x16 z16 = {0.f, 0.f, 0.f, 0.f, 0.f, 0.f, 0.f, 0.f, 0.f, 0.f, 0.f, 0.f, 0.f, 0.f, 0.f, 0.f};
    bf16x8 qf[16];
#pragma unroll
    for (int ks = 0; ks < 16; ++ks) qf[ks] = *(const bf16x8*)(Q + qrow * 1024 + hd * 256 + 16 * ks + 8 * hh);
    f32x16 s[8];
#pragma unroll
    for (int j = 0; j < 8; ++j) {
        const bf16* kp = Km + ((size_t)b * 256 + 32 * j + l31) * 1024 + hd * 256 + 8 * hh; f32x16 a = z16;
#pragma unroll
        for (int ks = 0; ks < 16; ++ks) a = MFMA32(*(const bf16x8*)(kp + 16 * ks), qf[ks], a);
        s[j] = a;
    }
    float m = -3.0e38f;
#pragma unroll
    for (int j = 0; j < 8; ++j)
#pragma unroll
        for (int i = 0; i < 16; ++i) m = fmaxf(m, s[j][i]);
    m = fmaxf(m, shx(m, 32, lane));
    float lsum = 0.f;
#pragma unroll
    for (int j = 0; j < 8; ++j)
#pragma unroll
        for (int i = 0; i < 16; ++i) { const float p = __expf(s[j][i] - m); s[j][i] = p; lsum += p; }
    lsum += shx(lsum, 32, lane);
    const float inv = 1.0f / lsum;
    bf16x8 pf[8][2];
#pragma unroll
    for (int j = 0; j < 8; ++j) { const f32x16 x = s[j] * inv; pf[j][0] = packstep(x, 0); pf[j][1] = packstep(x, 1); }
#pragma unroll 1
    for (int nh = 0; nh < 2; ++nh) {
        f32x16 o[4] = {z16, z16, z16, z16};
#pragma unroll
        for (int j = 0; j < 8; ++j)
#pragma unroll
            for (int sp = 0; sp < 2; ++sp)
#pragma unroll
                for (int nt = 0; nt < 4; ++nt) {
                    const bf16* vp = Vt + ((size_t)b * 1024 + hd * 256 + nh * 128 + 32 * nt + l31) * 256 + 32 * j + 16 * sp + 4 * hh;
                    const v2u lo = *(const v2u*)vp, hi = *(const v2u*)(vp + 8);
                    const v4u bw = {lo.x, lo.y, hi.x, hi.y};
                    o[nt] = MFMA32(pf[j][sp], __builtin_bit_cast(bf16x8, bw), o[nt]);
                }
#pragma unroll
        for (int nt = 0; nt < 4; ++nt)
#pragma unroll
            for (int i = 0; i < 16; ++i) OX[((size_t)b * SEQ + 32 * qt + crow(i, hh)) * 1024 + hd * 256 + nh * 128 + 32 * nt + l31] = f2bf(o[nt][i]);
    }
}


DI void xattn_stage(LAS unsigned char* lds, const bf16* __restrict__ src, size_t row_pitch, int tid) {
    asm volatile("" : "+v"(tid));
    v4u w[16];
#pragma unroll
    for (int i = 0; i < 16; ++i) { const int idx = tid + 512 * i, r = idx >> 5, c = idx & 31; w[i] = *(const v4u*)(src + (size_t)r * row_pitch + c * 8); }
#pragma unroll
    for (int i = 0; i < 16; ++i) { const int idx = tid + 512 * i, r = idx >> 5, c = idx & 31; *(LAS v4u*)(lds + r * 512 + ((c ^ (r & 31)) << 4)) = w[i]; }
}
DI void xattn_unit(LAS unsigned char* lds, int tid, const bf16* __restrict__ Q, const bf16* __restrict__ Km  , const bf16* __restrict__ Vt  , bf16* __restrict__ OX, int b, int hd, int qb) {
    const int lane = tid & 63, wave = __builtin_amdgcn_readfirstlane(tid >> 6), l31 = lane & 31, hh = lane >> 5;
    const f32x16 z16 = {0.f, 0.f, 0.f, 0.f, 0.f, 0.f, 0.f, 0.f, 0.f, 0.f, 0.f, 0.f, 0.f, 0.f, 0.f, 0.f};
    xattn_stage(lds, Km + (size_t)b * 256 * 1024 + hd * 256, 1024, tid);
    const size_t qrow0 = (size_t)b * SEQ + (size_t)qb * 256 + wave * 32;
    bf16x8 qf[16];
#pragma unroll
    for (int ks = 0; ks < 16; ++ks) qf[ks] = *(const bf16x8*)(Q + (qrow0 + l31) * 1024 + hd * 256 + 16 * ks + 8 * hh);
    __syncthreads();
    f32x16 s[8];
#pragma unroll
    for (int j = 0; j < 8; ++j) { const int row = 32 * j + l31; const LAS unsigned char* rp = lds + row * 512; f32x16 a = z16;
#pragma unroll
        for (int ks = 0; ks < 16; ++ks) a = MFMA32(*(const LAS bf16x8*)(rp + (((2 * ks + hh) ^ l31) << 4)), qf[ks], a);
        s[j] = a; }
    float m = -3.0e38f;
#pragma unroll
    for (int j = 0; j < 8; ++j)
#pragma unroll
        for (int i = 0; i < 16; ++i) m = fmaxf(m, s[j][i]);
    m = fmaxf(m, shx(m, 32, lane));
    float lsum = 0.f;
#pragma unroll
    for (int j = 0; j < 8; ++j)
#pragma unroll
        for (int i = 0; i < 16; ++i) { const float p = __expf(s[j][i] - m); s[j][i] = p; lsum += p; }
    lsum += shx(lsum, 32, lane);
    const float inv = 1.0f / lsum;
    bf16x8 pf[8][2];
#pragma unroll
    for (int j = 0; j < 8; ++j) { const f32x16 x = s[j] * inv; pf[j][0] = packstep(x, 0); pf[j][1] = packstep(x, 1); }
    __syncthreads();
    xattn_stage(lds, Vt + ((size_t)b * 1024 + hd * 256) * 256, 256, tid);
    __syncthreads();
#pragma unroll 1
    for (int nh = 0; nh < 2; ++nh) {
        f32x16 o[4] = {z16, z16, z16, z16};
#pragma unroll
        for (int j = 0; j < 8; ++j)
#pragma unroll
            for (int sp = 0; sp < 2; ++sp)
#pragma unroll
                for (int nt = 0; nt < 4; ++nt) {
                    const int row = nh * 128 + 32 * nt + l31; const LAS unsigned char* rp = lds + row * 512 + 8 * hh; const int c = 4 * j + 2 * sp;
                    const v2u lo = *(const LAS v2u*)(rp + ((c ^ l31) << 4)), hi = *(const LAS v2u*)(rp + (((c + 1) ^ l31) << 4));
                    const v4u bw = {lo.x, lo.y, hi.x, hi.y};
                    o[nt] = MFMA32(pf[j][sp], __builtin_bit_cast(bf16x8, bw), o[nt]);
                }
#pragma unroll
        for (int nt = 0; nt < 4; ++nt)
#pragma unroll
            for (int i = 0; i < 16; ++i) OX[(qrow0 + crow(i, hh)) * 1024 + hd * 256 + nh * 128 + 32 * nt + l31] = f2bf(o[nt][i]);
    }
    __syncthreads();
}

DI void router_task(const bf16* __restrict__ X, const bf16* __restrict__ wr  , const float* __restrict__ ssq, const float* __restrict__ bg, const float* __restrict__ be, LAS float* lg  ,
                    unsigned* ecnt  , int* __restrict__ TOKE, int* __restrict__ TOKP, float* __restrict__ TOKG, float* __restrict__ TRS, int t0, int lane) {
    asm volatile("" : "+v"(lane));
    const int l31 = lane & 31, hh = lane >> 5;
    const f32x16 z16 = {0.f, 0.f, 0.f, 0.f, 0.f, 0.f, 0.f, 0.f, 0.f, 0.f, 0.f, 0.f, 0.f, 0.f, 0.f, 0.f};
    f32x16 a0 = z16, a1 = z16;
    const bf16* xp = X + (size_t)(t0 + l31) * 1024 + 8 * hh; const bf16* w0 = wr + (size_t)l31 * 1024 + 8 * hh; const bf16* w1 = wr + (size_t)(32 + l31) * 1024 + 8 * hh;
#pragma unroll 8
    for (int ks = 0; ks < 64; ++ks) { const bf16x8 af = *(const bf16x8*)(xp + 16 * ks); a0 = MFMA32(af, *(const bf16x8*)(w0 + 16 * ks), a0); a1 = MFMA32(af, *(const bf16x8*)(w1 + 16 * ks), a1); }
#pragma unroll
    for (int i = 0; i < 16; ++i) { lg[crow(i, hh) * 40 + l31] = a0[i]; if (l31 < 4) lg[crow(i, hh) * 40 + 32 + l31] = a1[i]; }
    LDS_WAIT();
    if (lane < 32) {
        const int t = t0 + lane; const float rs = 1.0f / sqrtf(pg8::ssq16(ssq + (size_t)t * 16) * (1.0f / 1024.0f) + RMS_EPS);
        const LAS float* lr = lg + lane * 40;
        float gl[4]; int gi = 0; float gm = -3.0e38f;
#pragma unroll
        for (int k = 0; k < 4; ++k) { gl[k] = lr[k] * rs + bg[k]; if (gl[k] > gm) { gm = gl[k]; gi = k; } }
        float gs = 0.f;
#pragma unroll
        for (int k = 0; k < 4; ++k) gs += __expf(gl[k] - gm);
        const float gp = 1.0f / gs;
        float el[8]; int i0 = 0; float m0 = -3.0e38f;
#pragma unroll
        for (int k = 0; k < 8; ++k) { el[k] = lr[4 + gi * 8 + k] * rs + be[gi * 8 + k]; if (el[k] > m0) { m0 = el[k]; i0 = k; } }
        int i1 = 0; float m1 = -3.0e38f;
#pragma unroll
        for (int k = 0; k < 8; ++k) if (k != i0 && el[k] > m1) { m1 = el[k]; i1 = k; }
        const float p1 = __expf(m1 - m0); const float g0 = gp / (1.0f + p1), g1 = gp * p1 / (1.0f + p1);
        const int e0 = gi * 8 + i0, e1 = gi * 8 + i1;
        const int pos0 = (int)__hip_atomic_fetch_add(ecnt + e0, 1u, RLX_AGENT), pos1 = (int)__hip_atomic_fetch_add(ecnt + e1, 1u, RLX_AGENT);
        TOKE[t * 2] = e0; TOKE[t * 2 + 1] = e1; TOKP[t * 2] = pos0; TOKP[t * 2 + 1] = pos1; TOKG[t * 2] = g0; TOKG[t * 2 + 1] = g1; TRS[t] = rs;
    }
    LDS_WAIT();
}
DI void moe_tile_prefix(Frame& F, const unsigned* ecnt, int tid_p) {
    LAS int* tp = (LAS int*)(F.lds + TP_OFF);
    if (tid_p == 0) { int acc = 0;
#pragma unroll 1
        for (int e = 0; e < 32; ++e) { tp[e] = acc; int cn = (int)__hip_atomic_load(ecnt + e, RLX_AGENT); cn = cn < 0 ? 0 : (cn > 65536 ? 65536 : cn); acc += (cn + 255) >> 8; acc = acc > XS_ROWS / 256 ? XS_ROWS / 256 : acc; }
        tp[32] = acc; }
    __syncthreads();
}
#ifndef DBG_SKIP_MIX
#define DBG_SKIP_MIX 0
#endif
#ifndef DBG_SKIP_XATTN
#define DBG_SKIP_XATTN 0
#endif
#ifndef DBG_NO_ATTN
#define DBG_NO_ATTN 0
#endif
#ifndef DBG_NO_MLSTM
#define DBG_NO_MLSTM 0
#endif
#ifndef DBG_NO_S5
#define DBG_NO_S5 0
#endif
#ifndef DBG_S5_NOSCAN
#define DBG_S5_NOSCAN 0
#endif
#ifndef DBG_S5_TWICE
#define DBG_S5_TWICE 0
#endif
#ifndef DBG_DUP
#define DBG_DUP 0
#endif
#ifndef DBG_SKIP_MOE
#define DBG_SKIP_MOE 0
#endif
constexpr int PH2_IMG = 0, PH2_CW = 20480, PH2_VST = 25600, PH2_WSC = 62464;
constexpr int PH4_CW = 0, PH4_WSC = 5120, PH4_HST = 13312;

__global__ void __launch_bounds__(NWAVES * 64, 2) fwd_kernel(Args args) {
    extern __shared__ __attribute__((aligned(16))) unsigned char lds[];
    Frame F;
    F.lds = (LAS unsigned char*)lds;
    F.tid = threadIdx.x; F.lane = F.tid & 63; F.wave = __builtin_amdgcn_readfirstlane(F.tid >> 6);
    F.G = gridDim.x; { const int bx = blockIdx.x; F.vcu = (F.G % 8 == 0) ? (bx % 8) * (F.G / 8) + bx / 8 : bx; }
    F.ctl = (gu32*)(args.ws + WS_CTL);
    const int wave_u = F.wave;
    volatile LAS unsigned* MISC = (volatile LAS unsigned*)(F.lds + MISC_OFF);
    for (int u = F.tid; u < (LDS_BYTES - LDSCTL_OFF) / 4; u += NWAVES * 64) ((LAS unsigned*)(F.lds + LDSCTL_OFF))[u] = 0u;
    __syncthreads();
    XcdBarrier bar = xcd_barrier_post((unsigned*)(F.ctl + CW_BAR), MISC + 8);
#define GRID_BAR() do { XcdBarrier b2_ = bar; size_t bo_ = 0; asm volatile("" : "+s"(b2_.x), "+s"(bo_)); b2_.bar = bar.bar + bo_; xcd_barrier(b2_); } while (0)
    const int NGW = F.G * NWAVES;
#define Xb ((bf16*)(ws + WS_X))
#define Pb ((bf16*)(ws + WS_P))
#define Yb ((bf16*)(ws + WS_Y))
#define OPb ((bf16*)(ws + WS_OP))
#define RSA ((float*)(ws + WS_RSA))
#define SSQ ((float*)(ws + WS_SSQ))
#define Gt ((float*)(ws + WS_G))
#define LSE ((float*)(ws + WS_LSE))
#define S5ST ((float*)(ws + WS_S5ST))
#define MST ((float*)(ws + WS_MST))
#define MSC ((float*)(ws + WS_MISC + MI_MSC))
#define MPREV ((float*)(ws + WS_MISC + MI_MPREV))
#define TOKE ((int*)(ws + WS_MISC + MI_TOKE))
#define TOKP ((int*)(ws + WS_MISC + MI_TOKP))
#define TOKG ((float*)(ws + WS_MISC + MI_TOKG))
#define TRS ((float*)(ws + WS_MISC + MI_TRS))
#define RT ((int*)(ws + WS_MISC + MI_RT))
#define RGATE ((float*)(ws + WS_MISC + MI_RGATE))
#define RSS ((float*)(ws + WS_MISC + MI_RSS))
    if (F.tid < 40) ((const void**)(args.ws + WS_MISC + MI_PTAB))[F.tid] = F.tid < 39 ? (const void*)args.in[F.tid] : (const void*)args.out;
#pragma unroll 1
    for (int dup_ = 0; dup_ < (DBG_DUP & 1) + 1; ++dup_) { p0_prologue(F, args); __syncthreads(); }
    GRID_BAR();

#define PIN(k) (((const float* const*)(ws + WS_MISC + MI_PTAB))[k])
#define PHASE_IDS() int lane; asm volatile("v_mbcnt_lo_u32_b32 %0, -1, 0\n\tv_mbcnt_hi_u32_b32 %0, -1, %0" : "=v"(lane)); int wave = wave_u; asm volatile("" : "+s"(wave)); \
    const int tid_p = wave * 64 + lane, gw = F.vcu * NWAVES + wave; size_t wsoff_ = 0; asm volatile("" : "+s"(wsoff_)); unsigned char* ws = args.ws + wsoff_; (void)tid_p; (void)gw
    { constexpr int l = 0;
#pragma unroll 1
        for (int dup_ = 0; dup_ < ((DBG_DUP >> 1) & 1) + 1; ++dup_) {
        {
            PHASE_IDS();
            pg8::Gemm g{Xb, (const bf16*)(ws + WS_WIN) + (size_t)l * 2560 * 1024, T, 2560, D}; pg8::StaticOrder S; S.init(T, 2560, F.G, (int)blockIdx.x);
            pg8::EpiA E{Pb, Gt, RSA};
            pg8::gemm_phase<pg8::EpiA, pg8::StaticOrder, true, true>(F.lds + RING_OFF, g, S, E, wave);
        }
        if (l == 0) {
            __syncthreads();
            PHASE_IDS();
            pg8::Gemm g{(const bf16*)(ws + WS_AMEM), (const bf16*)(ws + WS_WKV), 512, 4096, D}; pg8::StaticOrder S; S.init(512, 4096, F.G, (int)blockIdx.x);
            pg8::EpiKV E{(bf16*)(ws + WS_KMEM), (bf16*)(ws + WS_VT)};
            pg8::gemm_phase<pg8::EpiKV, pg8::StaticOrder, true, true>(F.lds + RING_OFF, g, S, E, wave);
        }
        if (dup_ + 1 < ((DBG_DUP >> 1) & 1) + 1) { VM_WAIT(); __syncthreads(); }
        }
        GRID_BAR();
#if !DBG_SKIP_MIX
#pragma unroll 1
        for (int dup_ = 0; dup_ < ((DBG_DUP >> 2) & 1) + 1; ++dup_) {
        {
            PHASE_IDS();
            LAS float* imgL = (LAS float*)(F.lds + PH2_IMG); LAS float* cw = (LAS float*)(F.lds + PH2_CW);
            const int ph = F.vcu % 24, prank = F.vcu / 24, pnwg = (F.G - ph + 23) / 24;
            for (int i = tid_p; i < 5 * 64 * 16; i += NWAVES * 64) imgL[i] = ((const float*)(ws + WS_TAB + TAB_IMG))[ph * 5120 + i];
            for (int i = tid_p; i < 1280; i += NWAVES * 64) cw[i] = i < 1024 ? PIN(I_CONVW)[l * 1024 + i] : PIN(I_CONVB)[l * 256 + i - 1024];
            __syncthreads();
            LAS unsigned char* vst = F.lds + PH2_VST + wave * (32 * VST_PITCH); LAS float* wsc = (LAS float*)(F.lds + PH2_WSC) + wave * 256;
            { const int p = ph >> 3, h = ph & 7; const int dil = p == 0 ? 1 : (p == 1 ? 4 : 16); const int per = 512 / dil;
#pragma unroll 1
            for (int tk = prank * NWAVES + wave; tk < (DBG_NO_ATTN ? 0 : 1024); tk += pnwg * NWAVES) {
                const int b = tk >> 9, w = tk & 511;
                dil_attn_task(Pb, OPb + (size_t)p * T * 512, LSE + (size_t)p * T * 8, imgL, vst, dil, b, h, w / per, w % per, lane);
            } }
            const bf16* mlw = (const bf16*)(ws + WS_TAB + TAB_MLW) + (size_t)l * 4 * 3 * 4096;
#pragma unroll 1
            for (int tk = gw; tk < (DBG_NO_MLSTM ? 0 : 2048); tk += NGW) { const int b = tk >> 10, c = (tk >> 2) & 255, h = tk & 3;
                mlstm_b1_task(Pb, Gt, mlw, PIN(I_MGB) + l * 8, cw, wsc, MST, MSC, b, c, h, lane); }
            const bf16* bbL = (const bf16*)(ws + WS_TAB + TAB_S5BB) + (size_t)l * 16 * 2048; const float* abL = (const float*)(ws + WS_TAB + TAB_S5AB) + (size_t)l * 16 * 64 * 6;
#pragma unroll 1
            for (int tk = gw; tk < (DBG_NO_S5 ? 0 : 8192); tk += NGW) { const int b = tk >> 12, c = (tk >> 4) & 255, g = tk & 15;
                s5_end_task(Pb, bbL + (size_t)g * 2048, abL + (size_t)g * 384, S5ST, b, c, g, lane); }
        }
        if (dup_ + 1 < ((DBG_DUP >> 2) & 1) + 1) { VM_WAIT(); __syncthreads(); }
        }
        GRID_BAR();
        {
            PHASE_IDS();
            const int wt = wave * F.G + F.vcu;
            if (!DBG_NO_MLSTM && wt < 520) mlstm_scan_task(MST, MSC, MPREV, wt, lane);
            if (!DBG_NO_S5 && !DBG_S5_NOSCAN && wave == 3 && F.vcu < 32) s5_scan_task(S5ST, (const float*)(ws + WS_TAB + TAB_S5AB) + (size_t)l * 16 * 64 * 6, F.vcu, lane);
        }
        GRID_BAR();
#pragma unroll 1
        for (int dup_ = 0; dup_ < ((DBG_DUP >> 3) & 1) + 1; ++dup_) {
        {
            PHASE_IDS();
            LAS float* cw = (LAS float*)(F.lds + PH4_CW);
            for (int i = tid_p; i < 1280; i += NWAVES * 64) cw[i] = i < 1024 ? PIN(I_CONVW)[l * 1024 + i] : PIN(I_CONVB)[l * 256 + i - 1024];
            __syncthreads();
            const bf16* mlw = (const bf16*)(ws + WS_TAB + TAB_MLW) + (size_t)l * 4 * 3 * 4096;
#pragma unroll 1
            for (int tk = gw; tk < (DBG_NO_MLSTM ? 0 : 2048); tk += NGW) { const int b = tk >> 10, c = (tk >> 2) & 255, h = tk & 3;
                int lane2; asm volatile("v_mbcnt_lo_u32_b32 %0, -1, 0\n\tv_mbcnt_hi_u32_b32 %0, -1, %0" : "=v"(lane2));
                size_t zo_ = 0; asm volatile("" : "+s"(zo_));
                mlstm_b3_task(Pb + zo_, Gt + zo_, mlw + zo_, PIN(I_MGB) + l * 8 + zo_, PIN(I_MNORM) + l * 256 + zo_, PIN(I_MSKIP) + l * 256 + zo_, cw, (LAS float*)(F.lds + PH4_WSC) + wave * 256, F.lds + PH4_HST + wave * 9216, MST + zo_, MPREV + zo_, Yb + zo_, b, c, h, lane2); }
            __syncthreads();
        }
        {
            PHASE_IDS();
#pragma unroll 1
            for (int rep = 0; rep < (DBG_S5_TWICE ? 2 : 1); ++rep)
#pragma unroll 1
            for (int u2 = F.vcu; u2 < (DBG_NO_S5 ? 0 : 512); u2 += F.G)
              { const int u = u2; int ln_; asm volatile("v_mbcnt_lo_u32_b32 %0, -1, 0\n\tv_mbcnt_hi_u32_b32 %0, -1, %0" : "=v"(ln_));
                s5_out_unit(F, wave * 64 + ln_, Pb, (const bf16*)(ws + WS_TAB + TAB_S5BB) + (size_t)l * 16 * 2048, (const bf16*)(ws + WS_TAB + TAB_S5CC) + (size_t)l * 16 * 2048, (const float*)(ws + WS_TAB + TAB_S5AB) + (size_t)l * 16 * 64 * 6,
                            PIN(I_S5D) + l * 256, (const bf16*)(ws + WS_TAB + TAB_GLU) + (size_t)l * 65536, PIN(I_S5BGLU) + l * 256, PIN(I_S5ONORM) + l * 256, S5ST, rep ? (bf16*)(ws + WS_OP) : Yb, u >> 8, u & 255,
                            DBG_S5_TWICE ? (unsigned*)(ws + WS_OP + (rep ? 88 : 80) * MiB) + (size_t)u * 2560 : nullptr); }
#if DBG_S5_TWICE
            VM_WAIT(); __syncthreads();
        }
        {
            PHASE_IDS();
            for (int u = F.vcu; u < 512; u += F.G) { const size_t row0 = (size_t)u * 64;
                for (int i = tid_p; i < 64 * 64; i += 512) { const int r = i >> 6, c4 = i & 63; const v2u a = *(const v2u*)(Yb + (row0 + r) * 1024 + 256 + c4 * 4), b2 = *(const v2u*)((bf16*)(ws + WS_OP) + (row0 + r) * 1024 + 256 + c4 * 4);
                    if (a.x != b2.x || a.y != b2.y) __hip_atomic_store(F.ctl + 3, 1u, RLX_AGENT); }
                for (int k_ = 0; k_ < 5; ++k_) if (((const unsigned*)(ws + WS_OP + 80 * MiB))[(size_t)u * 2560 + k_ * 512 + tid_p] != ((const unsigned*)(ws + WS_OP + 88 * MiB))[(size_t)u * 2560 + k_ * 512 + tid_p]) __hip_atomic_store(F.ctl + 8 + k_, 1u, RLX_AGENT); }
#endif
        }
        {
            PHASE_IDS();
#pragma unroll 1
            for (int r = gw; r < T; r += NGW) {
                if (!DBG_NO_ATTN) attn_merge_row(OPb, LSE, PIN(I_AONORM) + l * 512, Yb, (size_t)r, lane); else *(v4u*)(Yb + (size_t)r * 1024 + 512 + lane * 8) = (v4u){0u, 0u, 0u, 0u};
                if (DBG_NO_MLSTM) *(v2u*)(Yb + (size_t)r * 1024 + lane * 4) = (v2u){0u, 0u};
                if (DBG_NO_S5) *(v2u*)(Yb + (size_t)r * 1024 + 256 + lane * 4) = (v2u){0u, 0u};
            }
        }
        if (dup_ + 1 < ((DBG_DUP >> 3) & 1) + 1) { VM_WAIT(); __syncthreads(); }
        }
        GRID_BAR();
        {
            PHASE_IDS();
            pg8::Gemm g{Yb, (const bf16*)(ws + WS_WOUT) + (size_t)l * 1048576, T, D, D}; pg8::StaticOrder S; S.init(T, D, F.G, (int)blockIdx.x);
            pg8::EpiRes E{Xb, SSQ};
            pg8::gemm_phase<pg8::EpiRes, pg8::StaticOrder, true, true>(F.lds + RING_OFF, g, S, E, wave);
        }
        GRID_BAR();
#else
        { PHASE_IDS();
        for (int m = gw; m < T; m += NGW) { const v4u a = *(const v4u*)(Xb + (size_t)m * D + lane * 16), b2 = *(const v4u*)(Xb + (size_t)m * D + lane * 16 + 8); float fa[8], fb[8]; unpack8(a, fa); unpack8(b2, fb); float s = 0.f;
            for (int e = 0; e < 8; ++e) s += fa[e] * fa[e] + fb[e] * fb[e]; s = wave_sum(s, lane); if (lane < 16) SSQ[(size_t)m * 16 + lane] = lane == 0 ? s : 0.f; } }
        GRID_BAR();
#endif
#if !DBG_SKIP_XATTN
#pragma unroll 1
        for (int dup_ = 0; dup_ < ((DBG_DUP >> 4) & 1) + 1; ++dup_) {
        {
            PHASE_IDS();
            pg8::Gemm g{Xb, (const bf16*)(ws + WS_WQ) + (size_t)l * 1048576, T, D, D}; pg8::StaticOrder S; S.init(T, D, F.G, (int)blockIdx.x);
            pg8::EpiQ E{(bf16*)(ws + WS_Q), SSQ};
            pg8::gemm_phase<pg8::EpiQ, pg8::StaticOrder, true, true>(F.lds + RING_OFF, g, S, E, wave);
        }
        if (dup_ + 1 < ((DBG_DUP >> 4) & 1) + 1) { VM_WAIT(); __syncthreads(); }
        }
        GRID_BAR();
#pragma unroll 1
        for (int dup_ = 0; dup_ < ((DBG_DUP >> 5) & 1) + 1; ++dup_) {
        { PHASE_IDS();
#pragma unroll 1
        for (int u2 = F.vcu; u2 < 512; u2 += F.G) { const int u = u2; int ln_; asm volatile("v_mbcnt_lo_u32_b32 %0, -1, 0\n\tv_mbcnt_hi_u32_b32 %0, -1, %0" : "=v"(ln_));
            xattn_unit(F.lds, wave * 64 + ln_, (const bf16*)(ws + WS_Q), (const bf16*)(ws + WS_KMEM) + (size_t)l * 512 * 1024, (const bf16*)(ws + WS_VT) + (size_t)l * 2 * 1024 * 256, (bf16*)(ws + WS_OX), u >> 8, (u >> 6) & 3, u & 63); } }
        if (dup_ + 1 < ((DBG_DUP >> 5) & 1) + 1) { VM_WAIT(); __syncthreads(); }
        }
        GRID_BAR();
        {
            PHASE_IDS();
            pg8::Gemm g{(const bf16*)(ws + WS_OX), (const bf16*)(ws + WS_WO) + (size_t)l * 1048576, T, D, D}; pg8::StaticOrder S; S.init(T, D, F.G, (int)blockIdx.x);
            pg8::EpiRes E{Xb, SSQ};
            pg8::gemm_phase<pg8::EpiRes, pg8::StaticOrder, true, true>(F.lds + RING_OFF, g, S, E, wave);
        }
        GRID_BAR();
#endif
#if !DBG_SKIP_MOE
        unsigned* ecnt = (unsigned*)(F.ctl + CW_ECNT) + l * 64;
        { PHASE_IDS();
        if (wave < 4) {
#pragma unroll 1
            for (int tk = F.vcu * 4 + wave; tk < T / 32; tk += F.G * 4)
                router_task(Xb, (const bf16*)(ws + WS_WR) + (size_t)l * 65536, SSQ, PIN(I_RBG) + l * 4, PIN(I_RBE) + l * 32, (LAS float*)(F.lds) + wave * 1280, ecnt, TOKE, TOKP, TOKG, TRS, tk * 32, lane);
        } }
        GRID_BAR();
#pragma unroll 1
        for (int dup_ = 0; dup_ < ((DBG_DUP >> 6) & 1) + 1; ++dup_) {
        {
            PHASE_IDS();
            moe_tile_prefix(F, ecnt, tid_p);
            const LAS int* tp = (const LAS int*)(F.lds + TP_OFF);
#pragma unroll 1
            for (int t = gw; t < T; t += NGW) {
                const v4u a = *(const v4u*)(Xb + (size_t)t * D + lane * 8), b2 = *(const v4u*)(Xb + (size_t)t * D + 512 + lane * 8);
#pragma unroll
                for (int k = 0; k < 2; ++k) { const int e = TOKE[t * 2 + k] & 31; int slot = 256 * tp[e] + TOKP[t * 2 + k]; slot = slot < 0 ? 0 : (slot >= XS_ROWS ? XS_ROWS - 1 : slot);
                    bf16* dst = (bf16*)(ws + WS_XS) + (size_t)slot * D; *(v4u*)(dst + lane * 8) = a; *(v4u*)(dst + 512 + lane * 8) = b2;
                    if (lane == 0) { RT[slot] = t * 2 + k; RGATE[slot] = TOKG[t * 2 + k]; RSS[slot] = TRS[t]; } }
            }
            if (F.vcu < 32) { const int e = F.vcu; int lo = 256 * tp[e] + (int)__hip_atomic_load(ecnt + e, RLX_AGENT); const int hi = 256 * tp[e + 1]; lo = lo < 256 * tp[e] ? 256 * tp[e] : lo;
                for (int s = lo + tid_p; s < hi; s += NWAVES * 64) { RT[s] = -1; RGATE[s] = 0.f; RSS[s] = 0.f; } }
        }
        if (dup_ + 1 < ((DBG_DUP >> 6) & 1) + 1) { VM_WAIT(); __syncthreads(); }
        }
        GRID_BAR();
#pragma unroll 1
        for (int dup_ = 0; dup_ < ((DBG_DUP >> 7) & 1) + 1; ++dup_) {
        {
            PHASE_IDS();
            pg8::Gemm g{(const bf16*)(ws + WS_XS), (const bf16*)(ws + WS_WGU) + (size_t)l * 32 * 1048576, XS_ROWS, 32 * 1024, D}; pg8::MoeOrder S{(const LAS int*)(F.lds + TP_OFF), F.G, F.vcu};
            pg8::EpiGU E{(bf16*)(ws + WS_H), RSS};
            pg8::gemm_phase<pg8::EpiGU, pg8::MoeOrder, true, true>(F.lds + RING_OFF, g, S, E, wave);
        }
        if (dup_ + 1 < ((DBG_DUP >> 7) & 1) + 1) { VM_WAIT(); __syncthreads(); }
        }
        GRID_BAR();
#pragma unroll 1
        for (int dup_ = 0; dup_ < ((DBG_DUP >> 8) & 1) + 1; ++dup_) {
        {
            PHASE_IDS();
            pg8::Gemm g{(const bf16*)(ws + WS_H), (const bf16*)(ws + WS_WDN) + (size_t)l * 32 * 524288, XS_ROWS, 32 * 1024, 512}; pg8::MoeOrder S{(const LAS int*)(F.lds + TP_OFF), F.G, F.vcu};
            pg8::EpiDN E{(bf16*)(ws + WS_YP), RT, RGATE};
            pg8::gemm_phase<pg8::EpiDN, pg8::MoeOrder, true, true>(F.lds + RING_OFF, g, S, E, wave);
        }
        if (dup_ + 1 < ((DBG_DUP >> 8) & 1) + 1) { VM_WAIT(); __syncthreads(); }
        }
        GRID_BAR();
#endif
        {
            PHASE_IDS();
            const bf16* Y0 = (const bf16*)(ws + WS_YP); const bf16* Y1 = Y0 + (size_t)T * D; const float* fn = PIN(I_FNORM);
#pragma unroll 1
            for (int t = gw; t < T; t += NGW) {
                float v[16];
                { const v4u a = *(const v4u*)(Xb + (size_t)t * D + lane * 16), b2 = *(const v4u*)(Xb + (size_t)t * D + lane * 16 + 8); float fa[8], fb[8]; unpack8(a, fa); unpack8(b2, fb);
#pragma unroll
                  for (int e = 0; e < 8; ++e) { v[e] = fa[e]; v[8 + e] = fb[e]; } }
#if !DBG_SKIP_MOE
                { const v4u a = *(const v4u*)(Y0 + (size_t)t * D + lane * 16), b2 = *(const v4u*)(Y0 + (size_t)t * D + lane * 16 + 8); float fa[8], fb[8]; unpack8(a, fa); unpack8(b2, fb);
#pragma unroll
                  for (int e = 0; e < 8; ++e) { v[e] += fa[e]; v[8 + e] += fb[e]; } }
                { const v4u a = *(const v4u*)(Y1 + (size_t)t * D + lane * 16), b2 = *(const v4u*)(Y1 + (size_t)t * D + lane * 16 + 8); float fa[8], fb[8]; unpack8(a, fa); unpack8(b2, fb);
#pragma unroll
                  for (int e = 0; e < 8; ++e) { v[e] += fa[e]; v[8 + e] += fb[e]; } }
#endif
                if (l + 1 < NLAYER) {
                    v4u o0, o1; o0.x = pk2(v[0], v[1]); o0.y = pk2(v[2], v[3]); o0.z = pk2(v[4], v[5]); o0.w = pk2(v[6], v[7]); o1.x = pk2(v[8], v[9]); o1.y = pk2(v[10], v[11]); o1.z = pk2(v[12], v[13]); o1.w = pk2(v[14], v[15]);
                    *(v4u*)(Xb + (size_t)t * D + lane * 16) = o0; *(v4u*)(Xb + (size_t)t * D + lane * 16 + 8) = o1;
                    float fa[8], fb[8]; unpack8(o0, fa); unpack8(o1, fb); float s = 0.f;
#pragma unroll
                    for (int e = 0; e < 8; ++e) s += fa[e] * fa[e] + fb[e] * fb[e];
                    s = wave_sum(s, lane); if (lane == 0) RSA[t] = 1.0f / sqrtf(s * (1.0f / D) + RMS_EPS);
                } else {
                    float s = 0.f;
#pragma unroll
                    for (int e = 0; e < 16; ++e) s += v[e] * v[e];
                    const float rs = 1.0f / sqrtf(wave_sum(s, lane) * (1.0f / D) + RMS_EPS) * (!DBG_S5_TWICE ? 1.0f : (__hip_atomic_load(F.ctl + 10, RLX_AGENT) ? __builtin_nanf("") : (__hip_atomic_load(F.ctl + 12, RLX_AGENT) ? 10.0f : (__hip_atomic_load(F.ctl + 11, RLX_AGENT) ? 3.0f : (__hip_atomic_load(F.ctl + 9, RLX_AGENT) ? 0.0f : (__hip_atomic_load(F.ctl + 8, RLX_AGENT) ? -1.0f : 1.0f))))));
#pragma unroll
                    for (int q = 0; q < 4; ++q) { const f32x4 gn = *(const f32x4*)(fn + lane * 16 + 4 * q); f32x4 o = {v[4 * q] * rs * gn[0], v[4 * q + 1] * rs * gn[1], v[4 * q + 2] * rs * gn[2], v[4 * q + 3] * rs * gn[3]};
                        *(f32x4*)(((float*)PIN(39)) + (size_t)t * D + lane * 16 + 4 * q) = o; }
                }
            }
        }
        if (l + 1 < NLAYER) GRID_BAR();
    }
    { constexpr int l = 1;
#pragma unroll 1
        for (int dup_ = 0; dup_ < ((DBG_DUP >> 1) & 1) + 1; ++dup_) {
        {
            PHASE_IDS();
            pg8::Gemm g{Xb, (const bf16*)(ws + WS_WIN) + (size_t)l * 2560 * 1024, T, 2560, D}; pg8::StaticOrder S; S.init(T, 2560, F.G, (int)blockIdx.x);
            pg8::EpiA E{Pb, Gt, RSA};
            pg8::gemm_phase<pg8::EpiA, pg8::StaticOrder, true, true>(F.lds + RING_OFF, g, S, E, wave);
        }
        if (l == 0) {
            __syncthreads();
            PHASE_IDS();
            pg8::Gemm g{(const bf16*)(ws + WS_AMEM), (const bf16*)(ws + WS_WKV), 512, 4096, D}; pg8::StaticOrder S; S.init(512, 4096, F.G, (int)blockIdx.x);
            pg8::EpiKV E{(bf16*)(ws + WS_KMEM), (bf16*)(ws + WS_VT)};
            pg8::gemm_phase<pg8::EpiKV, pg8::StaticOrder, true, true>(F.lds + RING_OFF, g, S, E, wave);
        }
        if (dup_ + 1 < ((DBG_DUP >> 1) & 1) + 1) { VM_WAIT(); __syncthreads(); }
        }
        GRID_BAR();
#if !DBG_SKIP_MIX
#pragma unroll 1
        for (int dup_ = 0; dup_ < ((DBG_DUP >> 2) & 1) + 1; ++dup_) {
        {
            PHASE_IDS();
            LAS float* imgL = (LAS float*)(F.lds + PH2_IMG); LAS float* cw = (LAS float*)(F.lds + PH2_CW);
            const int ph = F.vcu % 24, prank = F.vcu / 24, pnwg = (F.G - ph + 23) / 24;
            for (int i = tid_p; i < 5 * 64 * 16; i += NWAVES * 64) imgL[i] = ((const float*)(ws + WS_TAB + TAB_IMG))[ph * 5120 + i];
            for (int i = tid_p; i < 1280; i += NWAVES * 64) cw[i] = i < 1024 ? PIN(I_CONVW)[l * 1024 + i] : PIN(I_CONVB)[l * 256 + i - 1024];
            __syncthreads();
            LAS unsigned char* vst = F.lds + PH2_VST + wave * (32 * VST_PITCH); LAS float* wsc = (LAS float*)(F.lds + PH2_WSC) + wave * 256;
            { const int p = ph >> 3, h = ph & 7; const int dil = p == 0 ? 1 : (p == 1 ? 4 : 16); const int per = 512 / dil;
#pragma unroll 1
            for (int tk = prank * NWAVES + wave; tk < (DBG_NO_ATTN ? 0 : 1024); tk += pnwg * NWAVES) {
                const int b = tk >> 9, w = tk & 511;
                dil_attn_task(Pb, OPb + (size_t)p * T * 512, LSE + (size_t)p * T * 8, imgL, vst, dil, b, h, w / per, w % per, lane);
            } }
            const bf16* mlw = (const bf16*)(ws + WS_TAB + TAB_MLW) + (size_t)l * 4 * 3 * 4096;
#pragma unroll 1
            for (int tk = gw; tk < (DBG_NO_MLSTM ? 0 : 2048); tk += NGW) { const int b = tk >> 10, c = (tk >> 2) & 255, h = tk & 3;
                mlstm_b1_task(Pb, Gt, mlw, PIN(I_MGB) + l * 8, cw, wsc, MST, MSC, b, c, h, lane); }
            const bf16* bbL = (const bf16*)(ws + WS_TAB + TAB_S5BB) + (size_t)l * 16 * 2048; const float* abL = (const float*)(ws + WS_TAB + TAB_S5AB) + (size_t)l * 16 * 64 * 6;
#pragma unroll 1
            for (int tk = gw; tk < (DBG_NO_S5 ? 0 : 8192); tk += NGW) { const int b = tk >> 12, c = (tk >> 4) & 255, g = tk & 15;
                s5_end_task(Pb, bbL + (size_t)g * 2048, abL + (size_t)g * 384, S5ST, b, c, g, lane); }
        }
        if (dup_ + 1 < ((DBG_DUP >> 2) & 1) + 1) { VM_WAIT(); __syncthreads(); }
        }
        GRID_BAR();
        {
            PHASE_IDS();
            const int wt = wave * F.G + F.vcu;
            if (!DBG_NO_MLSTM && wt < 520) mlstm_scan_task(MST, MSC, MPREV, wt, lane);
            if (!DBG_NO_S5 && !DBG_S5_NOSCAN && wave == 3 && F.vcu < 32) s5_scan_task(S5ST, (const float*)(ws + WS_TAB + TAB_S5AB) + (size_t)l * 16 * 64 * 6, F.vcu, lane);
        }
        GRID_BAR();
#pragma unroll 1
        for (int dup_ = 0; dup_ < ((DBG_DUP >> 3) & 1) + 1; ++dup_) {
        {
            PHASE_IDS();
            LAS float* cw = (LAS float*)(F.lds + PH4_CW);
            for (int i = tid_p; i < 1280; i += NWAVES * 64) cw[i] = i < 1024 ? PIN(I_CONVW)[l * 1024 + i] : PIN(I_CONVB)[l * 256 + i - 1024];
            __syncthreads();
            const bf16* mlw = (const bf16*)(ws + WS_TAB + TAB_MLW) + (size_t)l * 4 * 3 * 4096;
#pragma unroll 1
            for (int tk = gw; tk < (DBG_NO_MLSTM ? 0 : 2048); tk += NGW) { const int b = tk >> 10, c = (tk >> 2) & 255, h = tk & 3;
                int lane2; asm volatile("v_mbcnt_lo_u32_b32 %0, -1, 0\n\tv_mbcnt_hi_u32_b32 %0, -1, %0" : "=v"(lane2));
                size_t zo_ = 0; asm volatile("" : "+s"(zo_));
                mlstm_b3_task(Pb + zo_, Gt + zo_, mlw + zo_, PIN(I_MGB) + l * 8 + zo_, PIN(I_MNORM) + l * 256 + zo_, PIN(I_MSKIP) + l * 256 + zo_, cw, (LAS float*)(F.lds + PH4_WSC) + wave * 256, F.lds + PH4_HST + wave * 9216, MST + zo_, MPREV + zo_, Yb + zo_, b, c, h, lane2); }
            __syncthreads();
        }
        {
            PHASE_IDS();
#pragma unroll 1
            for (int rep = 0; rep < (DBG_S5_TWICE ? 2 : 1); ++rep)
#pragma unroll 1
            for (int u2 = F.vcu; u2 < (DBG_NO_S5 ? 0 : 512); u2 += F.G)
              { const int u = u2; int ln_; asm volatile("v_mbcnt_lo_u32_b32 %0, -1, 0\n\tv_mbcnt_hi_u32_b32 %0, -1, %0" : "=v"(ln_));
                s5_out_unit(F, wave * 64 + ln_, Pb, (const bf16*)(ws + WS_TAB + TAB_S5BB) + (size_t)l * 16 * 2048, (const bf16*)(ws + WS_TAB + TAB_S5CC) + (size_t)l * 16 * 2048, (const float*)(ws + WS_TAB + TAB_S5AB) + (size_t)l * 16 * 64 * 6,
                            PIN(I_S5D) + l * 256, (const bf16*)(ws + WS_TAB + TAB_GLU) + (size_t)l * 65536, PIN(I_S5BGLU) + l * 256, PIN(I_S5ONORM) + l * 256, S5ST, rep ? (bf16*)(ws + WS_OP) : Yb, u >> 8, u & 255,
                            DBG_S5_TWICE ? (unsigned*)(ws + WS_OP + (rep ? 88 : 80) * MiB) + (size_t)u * 2560 : nullptr); }
#if DBG_S5_TWICE
            VM_WAIT(); __syncthreads();
        }
        {
            PHASE_IDS();
            for (int u = F.vcu; u < 512; u += F.G) { const size_t row0 = (size_t)u * 64;
                for (int i = tid_p; i < 64 * 64; i += 512) { const int r = i >> 6, c4 = i & 63; const v2u a = *(const v2u*)(Yb + (row0 + r) * 1024 + 256 + c4 * 4), b2 = *(const v2u*)((bf16*)(ws + WS_OP) + (row0 + r) * 1024 + 256 + c4 * 4);
                    if (a.x != b2.x || a.y != b2.y) __hip_atomic_store(F.ctl + 3, 1u, RLX_AGENT); }
                for (int k_ = 0; k_ < 5; ++k_) if (((const unsigned*)(ws + WS_OP + 80 * MiB))[(size_t)u * 2560 + k_ * 512 + tid_p] != ((const unsigned*)(ws + WS_OP + 88 * MiB))[(size_t)u * 2560 + k_ * 512 + tid_p]) __hip_atomic_store(F.ctl + 8 + k_, 1u, RLX_AGENT); }
#endif
        }
        {
            PHASE_IDS();
#pragma unroll 1
            for (int r = gw; r < T; r += NGW) {
                if (!DBG_NO_ATTN) attn_merge_row(OPb, LSE, PIN(I_AONORM) + l * 512, Yb, (size_t)r, lane); else *(v4u*)(Yb + (size_t)r * 1024 + 512 + lane * 8) = (v4u){0u, 0u, 0u, 0u};
                if (DBG_NO_MLSTM) *(v2u*)(Yb + (size_t)r * 1024 + lane * 4) = (v2u){0u, 0u};
                if (DBG_NO_S5) *(v2u*)(Yb + (size_t)r * 1024 + 256 + lane * 4) = (v2u){0u, 0u};
            }
        }
        if (dup_ + 1 < ((DBG_DUP >> 3) & 1) + 1) { VM_WAIT(); __syncthreads(); }
        }
        GRID_BAR();
        {
            PHASE_IDS();
            pg8::Gemm g{Yb, (const bf16*)(ws + WS_WOUT) + (size_t)l * 1048576, T, D, D}; pg8::StaticOrder S; S.init(T, D, F.G, (int)blockIdx.x);
            pg8::EpiRes E{Xb, SSQ};
            pg8::gemm_phase<pg8::EpiRes, pg8::StaticOrder, true, true>(F.lds + RING_OFF, g, S, E, wave);
        }
        GRID_BAR();
#else
        { PHASE_IDS();
        for (int m = gw; m < T; m += NGW) { const v4u a = *(const v4u*)(Xb + (size_t)m * D + lane * 16), b2 = *(const v4u*)(Xb + (size_t)m * D + lane * 16 + 8); float fa[8], fb[8]; unpack8(a, fa); unpack8(b2, fb); float s = 0.f;
            for (int e = 0; e < 8; ++e) s += fa[e] * fa[e] + fb[e] * fb[e]; s = wave_sum(s, lane); if (lane < 16) SSQ[(size_t)m * 16 + lane] = lane == 0 ? s : 0.f; } }
        GRID_BAR();
#endif
#if !DBG_SKIP_XATTN
#pragma unroll 1
        for (int dup_ = 0; dup_ < ((DBG_DUP >> 4) & 1) + 1; ++dup_) {
        {
            PHASE_IDS();
            pg8::Gemm g{Xb, (const bf16*)(ws + WS_WQ) + (size_t)l * 1048576, T, D, D}; pg8::StaticOrder S; S.init(T, D, F.G, (int)blockIdx.x);
            pg8::EpiQ E{(bf16*)(ws + WS_Q), SSQ};
            pg8::gemm_phase<pg8::EpiQ, pg8::StaticOrder, true, true>(F.lds + RING_OFF, g, S, E, wave);
        }
        if (dup_ + 1 < ((DBG_DUP >> 4) & 1) + 1) { VM_WAIT(); __syncthreads(); }
        }
        GRID_BAR();
#pragma unroll 1
        for (int dup_ = 0; dup_ < ((DBG_DUP >> 5) & 1) + 1; ++dup_) {
        { PHASE_IDS();
#pragma unroll 1
        for (int u2 = F.vcu; u2 < 512; u2 += F.G) { const int u = u2; int ln_; asm volatile("v_mbcnt_lo_u32_b32 %0, -1, 0\n\tv_mbcnt_hi_u32_b32 %0, -1, %0" : "=v"(ln_));
            xattn_unit(F.lds, wave * 64 + ln_, (const bf16*)(ws + WS_Q), (const bf16*)(ws + WS_KMEM) + (size_t)l * 512 * 1024, (const bf16*)(ws + WS_VT) + (size_t)l * 2 * 1024 * 256, (bf16*)(ws + WS_OX), u >> 8, (u >> 6) & 3, u & 63); } }
        if (dup_ + 1 < ((DBG_DUP >> 5) & 1) + 1) { VM_WAIT(); __syncthreads(); }
        }
        GRID_BAR();
        {
            PHASE_IDS();
            pg8::Gemm g{(const bf16*)(ws + WS_OX), (const bf16*)(ws + WS_WO) + (size_t)l * 1048576, T, D, D}; pg8::StaticOrder S; S.init(T, D, F.G, (int)blockIdx.x);
            pg8::EpiRes E{Xb, SSQ};
            pg8::gemm_phase<pg8::EpiRes, pg8::StaticOrder, true, true>(F.lds + RING_OFF, g, S, E, wave);
        }
        GRID_BAR();
#endif
#if !DBG_SKIP_MOE
        unsigned* ecnt = (unsigned*)(F.ctl + CW_ECNT) + l * 64;
        { PHASE_IDS();
        if (wave < 4) {
#pragma unroll 1
            for (int tk = F.vcu * 4 + wave; tk < T / 32; tk += F.G * 4)
                router_task(Xb, (const bf16*)(ws + WS_WR) + (size_t)l * 65536, SSQ, PIN(I_RBG) + l * 4, PIN(I_RBE) + l * 32, (LAS float*)(F.lds) + wave * 1280, ecnt, TOKE, TOKP, TOKG, TRS, tk * 32, lane);
        } }
        GRID_BAR();
#pragma unroll 1
        for (int dup_ = 0; dup_ < ((DBG_DUP >> 6) & 1) + 1; ++dup_) {
        {
            PHASE_IDS();
            moe_tile_prefix(F, ecnt, tid_p);
            const LAS int* tp = (const LAS int*)(F.lds + TP_OFF);
#pragma unroll 1
            for (int t = gw; t < T; t += NGW) {
                const v4u a = *(const v4u*)(Xb + (size_t)t * D + lane * 8), b2 = *(const v4u*)(Xb + (size_t)t * D + 512 + lane * 8);
#pragma unroll
                for (int k = 0; k < 2; ++k) { const int e = TOKE[t * 2 + k] & 31; int slot = 256 * tp[e] + TOKP[t * 2 + k]; slot = slot < 0 ? 0 : (slot >= XS_ROWS ? XS_ROWS - 1 : slot);
                    bf16* dst = (bf16*)(ws + WS_XS) + (size_t)slot * D; *(v4u*)(dst + lane * 8) = a; *(v4u*)(dst + 512 + lane * 8) = b2;
                    if (lane == 0) { RT[slot] = t * 2 + k; RGATE[slot] = TOKG[t * 2 + k]; RSS[slot] = TRS[t]; } }
            }
            if (F.vcu < 32) { const int e = F.vcu; int lo = 256 * tp[e] + (int)__hip_atomic_load(ecnt + e, RLX_AGENT); const int hi = 256 * tp[e + 1]; lo = lo < 256 * tp[e] ? 256 * tp[e] : lo;
                for (int s = lo + tid_p; s < hi; s += NWAVES * 64) { RT[s] = -1; RGATE[s] = 0.f; RSS[s] = 0.f; } }
        }
        if (dup_ + 1 < ((DBG_DUP >> 6) & 1) + 1) { VM_WAIT(); __syncthreads(); }
        }
        GRID_BAR();
#pragma unroll 1
        for (int dup_ = 0; dup_ < ((DBG_DUP >> 7) & 1) + 1; ++dup_) {
        {
            PHASE_IDS();
            pg8::Gemm g{(const bf16*)(ws + WS_XS), (const bf16*)(ws + WS_WGU) + (size_t)l * 32 * 1048576, XS_ROWS, 32 * 1024, D}; pg8::MoeOrder S{(const LAS int*)(F.lds + TP_OFF), F.G, F.vcu};
            pg8::EpiGU E{(bf16*)(ws + WS_H), RSS};
            pg8::gemm_phase<pg8::EpiGU, pg8::MoeOrder, true, true>(F.lds + RING_OFF, g, S, E, wave);
        }
        if (dup_ + 1 < ((DBG_DUP >> 7) & 1) + 1) { VM_WAIT(); __syncthreads(); }
        }
        GRID_BAR();
#pragma unroll 1
        for (int dup_ = 0; dup_ < ((DBG_DUP >> 8) & 1) + 1; ++dup_) {
        {
            PHASE_IDS();
            pg8::Gemm g{(const bf16*)(ws + WS_H), (const bf16*)(ws + WS_WDN) + (size_t)l * 32 * 524288, XS_ROWS, 32 * 1024, 512}; pg8::MoeOrder S{(const LAS int*)(F.lds + TP_OFF), F.G, F.vcu};
            pg8::EpiDN E{(bf16*)(ws + WS_YP), RT, RGATE};
            pg8::gemm_phase<pg8::EpiDN, pg8::MoeOrder, true, true>(F.lds + RING_OFF, g, S, E, wave);
        }
        if (dup_ + 1 < ((DBG_DUP >> 8) & 1) + 1) { VM_WAIT(); __syncthreads(); }
        }
        GRID_BAR();
#endif
        {
            PHASE_IDS();
            const bf16* Y0 = (const bf16*)(ws + WS_YP); const bf16* Y1 = Y0 + (size_t)T * D; const float* fn = PIN(I_FNORM);
#pragma unroll 1
            for (int t = gw; t < T; t += NGW) {
                float v[16];
                { const v4u a = *(const v4u*)(Xb + (size_t)t * D + lane * 16), b2 = *(const v4u*)(Xb + (size_t)t * D + lane * 16 + 8); float fa[8], fb[8]; unpack8(a, fa); unpack8(b2, fb);
#pragma unroll
                  for (int e = 0; e < 8; ++e) { v[e] = fa[e]; v[8 + e] = fb[e]; } }
#if !DBG_SKIP_MOE
                { const v4u a = *(const v4u*)(Y0 + (size_t)t * D + lane * 16), b2 = *(const v4u*)(Y0 + (size_t)t * D + lane * 16 + 8); float fa[8], fb[8]; unpack8(a, fa); unpack8(b2, fb);
#pragma unroll
                  for (int e = 0; e < 8; ++e) { v[e] += fa[e]; v[8 + e] += fb[e]; } }
                { const v4u a = *(const v4u*)(Y1 + (size_t)t * D + lane * 16), b2 = *(const v4u*)(Y1 + (size_t)t * D + lane * 16 + 8); float fa[8], fb[8]; unpack8(a, fa); unpack8(b2, fb);
#pragma unroll
                  for (int e = 0; e < 8; ++e) { v[e] += fa[e]; v[8 + e] += fb[e]; } }
#endif
                if (l + 1 < NLAYER) {
                    v4u o0, o1; o0.x = pk2(v[0], v[1]); o0.y = pk2(v[2], v[3]); o0.z = pk2(v[4], v[5]); o0.w = pk2(v[6], v[7]); o1.x = pk2(v[8], v[9]); o1.y = pk2(v[10], v[11]); o1.z = pk2(v[12], v[13]); o1.w = pk2(v[14], v[15]);
                    *(v4u*)(Xb + (size_t)t * D + lane * 16) = o0; *(v4u*)(Xb + (size_t)t * D + lane * 16 + 8) = o1;
                    float fa[8], fb[8]; unpack8(o0, fa); unpack8(o1, fb); float s = 0.f;
#pragma unroll
                    for (int e = 0; e < 8; ++e) s += fa[e] * fa[e] + fb[e] * fb[e];
                    s = wave_sum(s, lane); if (lane == 0) RSA[t] = 1.0f / sqrtf(s * (1.0f / D) + RMS_EPS);
                } else {
                    float s = 0.f;
#pragma unroll
                    for (int e = 0; e < 16; ++e) s += v[e] * v[e];
                    const float rs = 1.0f / sqrtf(wave_sum(s, lane) * (1.0f / D) + RMS_EPS) * (!DBG_S5_TWICE ? 1.0f : (__hip_atomic_load(F.ctl + 10, RLX_AGENT) ? __builtin_nanf("") : (__hip_atomic_load(F.ctl + 12, RLX_AGENT) ? 10.0f : (__hip_atomic_load(F.ctl + 11, RLX_AGENT) ? 3.0f : (__hip_atomic_load(F.ctl + 9, RLX_AGENT) ? 0.0f : (__hip_atomic_load(F.ctl + 8, RLX_AGENT) ? -1.0f : 1.0f))))));
#pragma unroll
                    for (int q = 0; q < 4; ++q) { const f32x4 gn = *(const f32x4*)(fn + lane * 16 + 4 * q); f32x4 o = {v[4 * q] * rs * gn[0], v[4 * q + 1] * rs * gn[1], v[4 * q + 2] * rs * gn[2], v[4 * q + 3] * rs * gn[3]};
                        *(f32x4*)(((float*)PIN(39)) + (size_t)t * D + lane * 16 + 4 * q) = o; }
                }
            }
        }
        if (l + 1 < NLAYER) GRID_BAR();
    }
}

extern "C" void kernel_launch(void* const* d_in, const int* in_sizes, int n_in, void* d_out, int out_size, void* d_ws, size_t ws_size, hipStream_t stream) {
    static int grid = 0;
    if (grid == 0) {
        if (n_in != 39 || in_sizes[0] != T * D || out_size != T * D || ws_size < WS_END) { fprintf(stderr, "kernel_launch: unexpected shapes (n_in %d, in0 %d, out %d, ws %zu; need ws >= %zu); nothing launched\n", n_in, n_in > 0 ? in_sizes[0] : -1, out_size, ws_size, (size_t)WS_END); grid = -1; return; }
        int dev = 0, cus = 0, per_cu = 0;
        if (hipGetDevice(&dev) != hipSuccess || hipDeviceGetAttribute(&cus, hipDeviceAttributeMultiprocessorCount, dev) != hipSuccess) { grid = -1; return; }
        if (hipFuncSetAttribute((const void*)fwd_kernel, hipFuncAttributeMaxDynamicSharedMemorySize, LDS_BYTES) != hipSuccess) { fprintf(stderr, "kernel_launch: hipFuncSetAttribute failed\n"); grid = -1; return; }
        if (hipOccupancyMaxActiveBlocksPerMultiprocessor(&per_cu, (const void*)fwd_kernel, NWAVES * 64, LDS_BYTES) != hipSuccess || per_cu < 1) { fprintf(stderr, "kernel_launch: occupancy query reports %d blocks per CU; nothing launched\n", per_cu); (void)hipGetLastError(); grid = -1; return; }
        grid = cus;
    }
    if (grid < 0) return;
    if (hipMemsetAsync((char*)d_ws + WS_CTL, 0, CTL_ZERO_BYTES, stream) != hipSuccess) return;
    Args a{};
    for (int i = 0; i < 39; ++i) a.in[i] = (const float*)d_in[i];
    a.out = (float*)d_out; a.ws = (unsigned char*)d_ws;
    hipLaunchKernelGGL(fwd_kernel, dim3(grid), dim3(NWAVES * 64), LDS_BYTES, stream, a);
}
```

```cpp
#include <hip/hip_runtime.h>
#include <cstdio>
#include <cstdint>
#include <cmath>
namespace pg8 {
#define PG8_LAS __attribute__((address_space(3)))
typedef unsigned short bf16_t;
typedef short bf16x8 __attribute__((ext_vector_type(8)));
typedef float f32x4 __attribute__((ext_vector_type(4)));
typedef unsigned u32x4 __attribute__((ext_vector_type(4)));
constexpr int BM = 256, BK = 64, HALF = 128, HTB = HALF * BK * 2  , STAGE_BYTES = 8 * HTB, NXCD = 8, WGM = 8;

__host__ __device__ __forceinline__ int lds_byte(int r, int c) { const int st = (r >> 4) * 2 + (c >> 5), rr = r & 15, cc = c & 31, ob = rr * 64 + cc * 2; return st * 1024 + (ob ^ (((ob >> 9) & 1) << 5)); }
__host__ __device__ __forceinline__ void stage_rc(int b, int& R, int& C) { const int st = b / 1024, sb = b % 1024, swz = sb ^ (((sb >> 9) & 1) << 5); R = (st >> 1) * 16 + swz / 64; C = (st & 1) * 32 + (swz % 64) / 2; }
__host__ __device__ __forceinline__ int perm32(int rho) { const int n = rho >> 4, i = rho & 15; return 8 * (i >> 2) + 4 * n + (i & 3); }

struct Unit { int pm, pn; };
struct Gemm { const bf16_t* A; const bf16_t* Bt; int M, N, K; };

struct StaticOrder {
    int nM, nN, nwg, G, c;
    __host__ __device__ void init(int M, int N, int G_, int c_) { nM = M / BM; nN = N / BM; nwg = nM * nN; G = G_; c = c_; }
    __host__ __device__ bool next(int i, Unit& u) const {
        const long L = (long)i * G + c; if (L >= nwg) return false;
        int wgid = (int)L; { const int q = nwg / NXCD, r = nwg % NXCD, xcd = wgid % NXCD, off = wgid / NXCD; wgid = (xcd < r ? xcd * (q + 1) : r * (q + 1) + (xcd - r) * q) + off; }
        const int nig = WGM * nN, gid = wgid / nig, fm = gid * WGM, gsz = (nM - fm) < WGM ? (nM - fm) : WGM;
        u.pm = fm + ((wgid % nig) % gsz); u.pn = (wgid % nig) / gsz; return true;
    }
    __device__ __forceinline__ void a_ready(const Unit&) const {}
    __device__ __forceinline__ void done(const Unit&) const {}
};
typedef float f32x2e __attribute__((ext_vector_type(2))); typedef __bf16 bf16x2e __attribute__((ext_vector_type(2)));
__device__ __forceinline__ unsigned cvtpk(float lo, float hi) { f32x2e v = {lo, hi}; bf16x2e b = __builtin_convertvector(v, bf16x2e); return __builtin_bit_cast(unsigned, b); }
__device__ __forceinline__ float bflo(unsigned w) { return __uint_as_float(w << 16); }
__device__ __forceinline__ float bfhi(unsigned w) { return __uint_as_float(w & 0xffff0000u); }
__device__ __forceinline__ u32x4 pack8v(const f32x4& v0, const f32x4& v1) { u32x4 w; w.x = cvtpk(v0[0], v0[1]); w.y = cvtpk(v0[2], v0[3]); w.z = cvtpk(v1[0], v1[1]); w.w = cvtpk(v1[2], v1[3]); return w; }
__device__ __forceinline__ float ssq16(const float* p) {
    const f32x4 a = *(const f32x4*)p, b = *(const f32x4*)(p + 4), c = *(const f32x4*)(p + 8), d = *(const f32x4*)(p + 12);
    return (((a[0] + a[1]) + (a[2] + a[3])) + ((b[0] + b[1]) + (b[2] + b[3]))) + (((c[0] + c[1]) + (c[2] + c[3])) + ((d[0] + d[1]) + (d[2] + d[3])));
}
constexpr int PW_ = 2560;

struct EpiA {
    static constexpr bool PERM = true, AFTER_DRAIN = false;
    bf16_t* P; float* G; const float* rsa;
    __device__ __forceinline__ void operator()(const f32x4 (&acc)[2][2][4][2], const Unit& u, int wr, int wc, int fr, int fq) const {
        const int row0 = u.pm * BM + wr * 64 + fr;
        if (u.pn == 9) {
            if (wc == 0 && fq == 0) {
#pragma unroll
                for (int ai = 0; ai < 2; ++ai)
#pragma unroll
                    for (int m = 0; m < 4; ++m) { const int row = row0 + ai * HALF + m * 16; const float s = rsa[row];
                        *(f32x4*)(G + (size_t)row * 8) = acc[ai][0][m][0] * s; *(f32x4*)(G + (size_t)row * 8 + 4) = acc[ai][0][m][1] * s; }
            }
            return;
        }
        const int col0 = u.pn * BM + wc * 32 + 8 * fq;
#pragma unroll
        for (int ai = 0; ai < 2; ++ai)
#pragma unroll
            for (int m = 0; m < 4; ++m) { const int row = row0 + ai * HALF + m * 16; const float s = rsa[row]; bf16_t* rowp = P + (size_t)row * PW_ + col0;
#pragma unroll
                for (int bj = 0; bj < 2; ++bj) { const f32x4 v0 = acc[ai][bj][m][0] * s, v1 = acc[ai][bj][m][1] * s; *(u32x4*)(rowp + bj * HALF) = pack8v(v0, v1); } }
    }
};
struct EpiRes {
    static constexpr bool PERM = true, AFTER_DRAIN = false;
    bf16_t* X; float* ssq;
    __device__ __forceinline__ void operator()(const f32x4 (&acc)[2][2][4][2], const Unit& u, int wr, int wc, int fr, int fq) const {
        const int row0 = u.pm * BM + wr * 64 + fr, col0 = u.pn * BM + wc * 32 + 8 * fq;
#pragma unroll
        for (int ai = 0; ai < 2; ++ai)
#pragma unroll
            for (int m = 0; m < 4; ++m) { const int row = row0 + ai * HALF + m * 16; bf16_t* rowp = X + (size_t)row * 1024 + col0; float ss = 0.f;
#pragma unroll
                for (int bj = 0; bj < 2; ++bj) { const u32x4 o = *(const u32x4*)(rowp + bj * HALF);
                    f32x4 v0 = acc[ai][bj][m][0], v1 = acc[ai][bj][m][1];
                    v0[0] += bflo(o.x); v0[1] += bfhi(o.x); v0[2] += bflo(o.y); v0[3] += bfhi(o.y); v1[0] += bflo(o.z); v1[1] += bfhi(o.z); v1[2] += bflo(o.w); v1[3] += bfhi(o.w);
                    const u32x4 w = pack8v(v0, v1); *(u32x4*)(rowp + bj * HALF) = w;
                    const float a0 = bflo(w.x), a1 = bfhi(w.x), a2 = bflo(w.y), a3 = bfhi(w.y), a4 = bflo(w.z), a5 = bfhi(w.z), a6 = bflo(w.w), a7 = bfhi(w.w);
                    ss += ((a0 * a0 + a1 * a1) + (a2 * a2 + a3 * a3)) + ((a4 * a4 + a5 * a5) + (a6 * a6 + a7 * a7)); }
                ss += __shfl_xor(ss, 16); ss += __shfl_xor(ss, 32);
                if (fq == 0) ssq[(size_t)row * 16 + u.pn * 4 + wc] = ss; }
    }
};
struct EpiQ {
    static constexpr bool PERM = true, AFTER_DRAIN = false;
    bf16_t* Q; const float* ssq;
    __device__ __forceinline__ void operator()(const f32x4 (&acc)[2][2][4][2], const Unit& u, int wr, int wc, int fr, int fq) const {
        const int row0 = u.pm * BM + wr * 64 + fr, col0 = u.pn * BM + wc * 32 + 8 * fq;
#pragma unroll
        for (int ai = 0; ai < 2; ++ai)
#pragma unroll
            for (int m = 0; m < 4; ++m) { const int row = row0 + ai * HALF + m * 16; const float s = 1.0f / sqrtf(ssq16(ssq + (size_t)row * 16) * (1.0f / 1024.0f) + 1e-6f); bf16_t* rowp = Q + (size_t)row * 1024 + col0;
#pragma unroll
                for (int bj = 0; bj < 2; ++bj) { const f32x4 v0 = acc[ai][bj][m][0] * s, v1 = acc[ai][bj][m][1] * s; *(u32x4*)(rowp + bj * HALF) = pack8v(v0, v1); } }
    }
};
struct EpiKV {
    static constexpr bool PERM = true, AFTER_DRAIN = false;
    bf16_t* Km; bf16_t* Vt;
    __device__ __forceinline__ void operator()(const f32x4 (&acc)[2][2][4][2], const Unit& u, int wr, int wc, int fr, int fq) const {
        const int row0 = u.pm * BM + wr * 64 + fr; const int l = u.pn >> 3, ct = u.pn & 7;
        if (ct < 4) {
            const int col0 = ct * BM + wc * 32 + 8 * fq;
#pragma unroll
            for (int ai = 0; ai < 2; ++ai)
#pragma unroll
                for (int m = 0; m < 4; ++m) { const int row = row0 + ai * HALF + m * 16; bf16_t* rowp = Km + ((size_t)l * 512 + row) * 1024 + col0;
#pragma unroll
                    for (int bj = 0; bj < 2; ++bj) *(u32x4*)(rowp + bj * HALF) = pack8v(acc[ai][bj][m][0], acc[ai][bj][m][1]); }
        } else {
            const int col0 = (ct - 4) * BM + wc * 32 + 8 * fq;
#pragma unroll
            for (int ai = 0; ai < 2; ++ai)
#pragma unroll
                for (int m = 0; m < 4; ++m) { const int row = row0 + ai * HALF + m * 16; const int b = row >> 8, key = row & 255;
#pragma unroll
                    for (int bj = 0; bj < 2; ++bj) { const u32x4 w = pack8v(acc[ai][bj][m][0], acc[ai][bj][m][1]);
                        bf16_t* vp = Vt + (((size_t)l * 2 + b) * 1024 + col0 + bj * HALF) * 256 + key;
                        vp[0 * 256] = (bf16_t)(w.x & 0xffffu); vp[1 * 256] = (bf16_t)(w.x >> 16); vp[2 * 256] = (bf16_t)(w.y & 0xffffu); vp[3 * 256] = (bf16_t)(w.y >> 16);
                        vp[4 * 256] = (bf16_t)(w.z & 0xffffu); vp[5 * 256] = (bf16_t)(w.z >> 16); vp[6 * 256] = (bf16_t)(w.w & 0xffffu); vp[7 * 256] = (bf16_t)(w.w >> 16); } }
        }
    }
};
struct EpiGU {
    static constexpr bool PERM = true, AFTER_DRAIN = false;
    bf16_t* H; const float* rss;
    __device__ __forceinline__ void operator()(const f32x4 (&acc)[2][2][4][2], const Unit& u, int wr, int wc, int fr, int fq) const {
        const int row0 = u.pm * BM + wr * 64 + fr, col0 = (u.pn & 3) * HALF + wc * 32 + 8 * fq;
#pragma unroll
        for (int ai = 0; ai < 2; ++ai)
#pragma unroll
            for (int m = 0; m < 4; ++m) { const int row = row0 + ai * HALF + m * 16; const float s = rss[row]; f32x4 h0, h1;
#pragma unroll
                for (int j = 0; j < 4; ++j) { const float a0 = acc[ai][0][m][0][j] * s, b0 = acc[ai][1][m][0][j] * s, a1 = acc[ai][0][m][1][j] * s, b1 = acc[ai][1][m][1][j] * s;
                    h0[j] = a0 / (1.0f + __expf(-a0)) * b0; h1[j] = a1 / (1.0f + __expf(-a1)) * b1; }
                *(u32x4*)(H + (size_t)row * 512 + col0) = pack8v(h0, h1); }
    }
};
struct EpiDN {
    static constexpr bool PERM = true, AFTER_DRAIN = false;
    bf16_t* YP; const int* rowtok; const float* rowgate;
    __device__ __forceinline__ void operator()(const f32x4 (&acc)[2][2][4][2], const Unit& u, int wr, int wc, int fr, int fq) const {
        const int row0 = u.pm * BM + wr * 64 + fr, col0 = (u.pn & 3) * BM + wc * 32 + 8 * fq;
#pragma unroll
        for (int ai = 0; ai < 2; ++ai)
#pragma unroll
            for (int m = 0; m < 4; ++m) { const int row = row0 + ai * HALF + m * 16; const int tk = rowtok[row];
                if (tk >= 0 && tk < 65536) { const float gte = rowgate[row]; bf16_t* rowp = YP + ((size_t)(tk & 1) * 32768 + (size_t)(tk >> 1)) * 1024 + col0;
#pragma unroll
                    for (int bj = 0; bj < 2; ++bj) { const f32x4 v0 = acc[ai][bj][m][0] * gte, v1 = acc[ai][bj][m][1] * gte; *(u32x4*)(rowp + bj * HALF) = pack8v(v0, v1); } } }
    }
};
struct MoeOrder {
    const PG8_LAS int* tp; int G, c;
    __device__ __forceinline__ bool next(int i, Unit& u) const {
        const int L = i * G + c; const int R = tp[32]; if (L >= 4 * R) return false;
        const int rt = L >> 2; int e = 0;
#pragma unroll 1
        for (int k = 1; k < 32; ++k) e = (tp[k] <= rt) ? k : e;
        u.pm = rt; u.pn = e * 4 + (L & 3); return true;
    }
    __device__ __forceinline__ void a_ready(const Unit&) const {}
    __device__ __forceinline__ void done(const Unit&) const {}
};
template <class Epi, class Sched, bool ALIGN_EPI = false, bool SP2 = false>
__device__ __forceinline__ void gemm_phase(PG8_LAS unsigned char* lds, const Gemm g, const Sched& S, const Epi& E, int wave_id  ) {
    int lane_raw; asm volatile("v_mbcnt_lo_u32_b32 %0, -1, 0\n\tv_mbcnt_hi_u32_b32 %0, -1, %0" : "=v"(lane_raw));
    const int tid_raw = wave_id * 64 + lane_raw;
    const int tid = tid_raw, wid = __builtin_amdgcn_readfirstlane(tid >> 6), lane = tid & 63, wr = wid >> 2, wc = wid & 3, fr = lane & 15, fq = lane >> 4;
    const int K = g.K, nt = K / BK;
    unsigned voffA[2], voffB[2];
#pragma unroll
    for (int i = 0; i < 2; ++i) { int R, C; stage_rc(tid * 16 + i * 8192, R, C); const int Rb = Epi::PERM ? ((R & ~31) + perm32(R & 31)) : R;
        voffA[i] = (unsigned)(R * K + C) * 2u; voffB[i] = (unsigned)(Rb * K + C) * 2u; }
    const size_t kstep = (size_t)(BK * 2);
    const size_t hstep = (size_t)HALF * K * 2;
    const size_t tstep = 2 * hstep;
    const unsigned ldsw = (unsigned)wid * 1024u;
    const int aoff = lds_byte(wr * 64 + fr, fq * 8), boff = lds_byte(wc * 32 + fr, fq * 8);
#define PG8_SA(b, h) (((b) * 2 + (h)) * HTB)
#define PG8_SB(b, h) ((4 + (b) * 2 + (h)) * HTB)
#define PG8_STAGE(bufoff, gbase, voff) do { _Pragma("unroll") for (int _i = 0; _i < 2; ++_i) \
        __builtin_amdgcn_global_load_lds((const unsigned*)((const char*)(gbase) + (voff)[_i]), (PG8_LAS unsigned*)(lds + (bufoff) + ldsw + _i * 8192), 16, 0, 0); } while (0)
#define PG8_LDA(dst, b, h) do { _Pragma("unroll") for (int m = 0; m < 4; ++m) _Pragma("unroll") for (int k = 0; k < 2; ++k) dst[m][k] = *(const PG8_LAS bf16x8*)(lds + PG8_SA(b, h) + aoff + m * 2048 + k * 1024); } while (0)
#define PG8_LDB(dst, b, h) do { _Pragma("unroll") for (int n = 0; n < 2; ++n) _Pragma("unroll") for (int k = 0; k < 2; ++k) dst[n][k] = *(const PG8_LAS bf16x8*)(lds + PG8_SB(b, h) + boff + n * 2048 + k * 1024); } while (0)
#define PG8_MMA(ai, bj, At, Bt) do { __builtin_amdgcn_s_setprio(1); _Pragma("unroll") for (int m = 0; m < 4; ++m) _Pragma("unroll") for (int n = 0; n < 2; ++n) _Pragma("unroll") for (int k = 0; k < 2; ++k) \
        acc[ai][bj][m][n] = __builtin_amdgcn_mfma_f32_16x16x32_bf16(Bt[n][k], At[m][k], acc[ai][bj][m][n], 0, 0, 0); __builtin_amdgcn_s_setprio(0); } while (0)
#define PG8_WAIT_V(n) asm volatile("s_waitcnt vmcnt(" #n ")" ::: "memory")
#define PG8_WAIT_L(n) asm volatile("s_waitcnt lgkmcnt(" #n ")" ::: "memory")
#define PG8_BAR __builtin_amdgcn_s_barrier()
#define PG8_SCHED __builtin_amdgcn_sched_barrier(0)
    Unit cur, nxt; int ui = 0;
    if (!S.next(0, cur)) return;
    f32x4 acc[2][2][4][2];
#pragma unroll
    for (int a = 0; a < 2; ++a)
#pragma unroll
        for (int b = 0; b < 2; ++b)
#pragma unroll
            for (int m = 0; m < 4; ++m)
#pragma unroll
                for (int n = 0; n < 2; ++n) acc[a][b][m][n] = (f32x4){0.f, 0.f, 0.f, 0.f};
    bf16x8 At[4][2], B0[2][2], B1[2][2];
    const char* cA = (const char*)g.A + (size_t)cur.pm * tstep; const char* cB = (const char*)g.Bt + (size_t)cur.pn * tstep;
    S.a_ready(cur);
    if constexpr (SP2) {
        PG8_STAGE(PG8_SB(0, 0), cB, voffB); PG8_STAGE(PG8_SB(0, 1), cB + hstep, voffB); PG8_STAGE(PG8_SA(0, 0), cA, voffA); PG8_STAGE(PG8_SA(0, 1), cA + hstep, voffA);
        if (wr == 1) PG8_BAR;
        PG8_WAIT_V(2); PG8_BAR;
        PG8_STAGE(PG8_SB(1, 0), cB + kstep, voffB); PG8_STAGE(PG8_SA(1, 0), cA + kstep, voffA); PG8_STAGE(PG8_SB(1, 1), cB + hstep + kstep, voffB);
        PG8_WAIT_V(6); PG8_BAR;
    } else {
        PG8_STAGE(PG8_SB(0, 0), cB, voffB); PG8_STAGE(PG8_SA(0, 0), cA, voffA); PG8_STAGE(PG8_SB(0, 1), cB + hstep, voffB); PG8_STAGE(PG8_SA(0, 1), cA + hstep, voffA);
        if (wr == 1) PG8_BAR;
        PG8_WAIT_V(4); PG8_BAR;
        PG8_STAGE(PG8_SB(1, 0), cB + kstep, voffB); PG8_STAGE(PG8_SA(1, 0), cA + kstep, voffA); PG8_STAGE(PG8_SB(1, 1), cB + hstep + kstep, voffB);
        PG8_WAIT_V(6); PG8_BAR;
    }
    for (;;) {
        const bool has_next = S.next(ui + 1, nxt);
        const char* nA = has_next ? (const char*)g.A + (size_t)nxt.pm * tstep : cA; const char* nB = has_next ? (const char*)g.Bt + (size_t)nxt.pn * tstep : cB;
        for (int t = 0; t < nt; t += 2) {
            const bool last = (t == nt - 2);
            const char* a1 = cA + (size_t)(t + 1) * kstep;
            const char* a2 = last ? nA : cA + (size_t)(t + 2) * kstep; const char* b2 = last ? nB : cB + (size_t)(t + 2) * kstep;
            const char* a3 = a2 + kstep; const char* b3 = b2 + kstep;
            if (last && has_next) S.a_ready(nxt);
            if constexpr (SP2) {
            PG8_LDB(B0, 0, 0); PG8_LDB(B1, 0, 1); PG8_SCHED; PG8_LDA(At, 0, 0); PG8_STAGE(PG8_SA(1, 1), a1 + hstep, voffA);
            PG8_WAIT_V(8); PG8_WAIT_L(0); PG8_BAR; PG8_MMA(0, 0, At, B0); PG8_MMA(0, 1, At, B1); PG8_BAR; PG8_SCHED;
            PG8_LDA(At, 0, 1); PG8_STAGE(PG8_SB(0, 0), b2, voffB); PG8_STAGE(PG8_SB(0, 1), b2 + hstep, voffB); PG8_STAGE(PG8_SA(0, 0), a2, voffA);
            PG8_WAIT_V(8); PG8_WAIT_L(0); PG8_BAR; PG8_MMA(1, 0, At, B0); PG8_MMA(1, 1, At, B1); PG8_BAR; PG8_SCHED;
            PG8_LDB(B0, 1, 0); PG8_LDB(B1, 1, 1); PG8_SCHED; PG8_LDA(At, 1, 0); PG8_STAGE(PG8_SA(0, 1), a2 + hstep, voffA);
            PG8_WAIT_V(8); PG8_WAIT_L(0); PG8_BAR; PG8_MMA(0, 0, At, B0); PG8_MMA(0, 1, At, B1); PG8_BAR; PG8_SCHED;
            PG8_LDA(At, 1, 1); PG8_STAGE(PG8_SB(1, 0), b3, voffB); PG8_STAGE(PG8_SB(1, 1), b3 + hstep, voffB); PG8_STAGE(PG8_SA(1, 0), a3, voffA);
            PG8_WAIT_V(8); PG8_WAIT_L(0); PG8_BAR; PG8_MMA(1, 0, At, B0); PG8_MMA(1, 1, At, B1); PG8_BAR; PG8_SCHED;
            } else {
            PG8_LDB(B0, 0, 0); PG8_SCHED; PG8_LDA(At, 0, 0); PG8_STAGE(PG8_SA(1, 1), a1 + hstep, voffA);
            PG8_WAIT_L(8); PG8_BAR; PG8_WAIT_L(0); PG8_MMA(0, 0, At, B0); PG8_BAR; PG8_SCHED;
            PG8_LDB(B1, 0, 1); PG8_STAGE(PG8_SB(0, 0), b2, voffB);
            PG8_BAR; PG8_WAIT_L(0); PG8_MMA(0, 1, At, B1); PG8_BAR;
            PG8_LDA(At, 0, 1); PG8_STAGE(PG8_SA(0, 0), a2, voffA);
            PG8_BAR; PG8_WAIT_L(0); PG8_MMA(1, 0, At, B0); PG8_BAR; PG8_SCHED;
            PG8_STAGE(PG8_SB(0, 1), b2 + hstep, voffB);
            PG8_WAIT_V(6); PG8_BAR; PG8_MMA(1, 1, At, B1); PG8_BAR;
            PG8_LDB(B0, 1, 0); PG8_SCHED; PG8_LDA(At, 1, 0); PG8_STAGE(PG8_SA(0, 1), a2 + hstep, voffA);
            PG8_WAIT_L(8); PG8_BAR; PG8_WAIT_L(0); PG8_MMA(0, 0, At, B0); PG8_BAR; PG8_SCHED;
            PG8_LDB(B1, 1, 1); PG8_STAGE(PG8_SB(1, 0), b3, voffB);
            PG8_BAR; PG8_WAIT_L(0); PG8_MMA(0, 1, At, B1); PG8_BAR;
            PG8_LDA(At, 1, 1); PG8_STAGE(PG8_SA(1, 0), a3, voffA);
            PG8_BAR; PG8_WAIT_L(0); PG8_MMA(1, 0, At, B0); PG8_BAR; PG8_SCHED;
            PG8_STAGE(PG8_SB(1, 1), b3 + hstep, voffB);
            PG8_WAIT_V(6); PG8_BAR; PG8_MMA(1, 1, At, B1); PG8_BAR;
            }
        }
        if constexpr (ALIGN_EPI) { if (wr == 0) PG8_BAR; }
        if constexpr (!Epi::AFTER_DRAIN) { E(acc, cur, wr, wc, fr, fq); S.done(cur); }
        if (!has_next) break;
#pragma unroll
        for (int a = 0; a < 2; ++a)
#pragma unroll
            for (int b = 0; b < 2; ++b)
#pragma unroll
                for (int m = 0; m < 4; ++m)
#pragma unroll
                    for (int n = 0; n < 2; ++n) acc[a][b][m][n] = (f32x4){0.f, 0.f, 0.f, 0.f};
        cur = nxt; cA = nA; cB = nB; ++ui;
        if constexpr (ALIGN_EPI) { if (wr == 1) PG8_BAR; }
    }
    PG8_WAIT_V(0);
    if constexpr (!ALIGN_EPI) { if (wr == 0) PG8_BAR; }
    PG8_BAR;
    if constexpr (Epi::AFTER_DRAIN) { E.fused(acc, cur, wr, wc, fr, fq, lds, wid, lane); S.done(cur); }
#undef PG8_SA
#undef PG8_SB
#undef PG8_STAGE
#undef PG8_LDA
#undef PG8_LDB
#undef PG8_MMA
#undef PG8_WAIT_V
#undef PG8_WAIT_L
#undef PG8_BAR
#undef PG8_SCHED
}
}
#ifndef DBG_S5_SYNTH
#define DBG_S5_SYNTH 0
#endif
#ifndef DBG_S5_TWICE
#define DBG_S5_TWICE 0
#endif
#ifndef DBG_S5_NOPERM
#define DBG_S5_NOPERM 0
#endif
#ifndef DBG_S5_LDSFILL
#define DBG_S5_LDSFILL 0
#endif
#ifndef DBG_S5_NOCARRY
#define DBG_S5_NOCARRY 0
#endif
constexpr int NWAVES = 8;
constexpr int BATCH = 2, SEQ = 16384, T = BATCH * SEQ, D = 1024, NLAYER = 2;
constexpr int PW = 2560;
constexpr int PC_MU = 0, PC_MO = 256, PC_SU = 512, PC_Q = 768, PC_K = 1280, PC_V = 1792;
constexpr float RMS_EPS = 1e-6f;
constexpr int XS_ROWS = 73728;
constexpr size_t MiB = 1u << 20;
constexpr size_t WS_CTL = 0, CTL_ZERO_BYTES = 1 * MiB;
constexpr size_t WS_WIN = 1 * MiB, WS_WOUT = 11 * MiB, WS_WQ = 15 * MiB, WS_WO = 19 * MiB, WS_WKV = 23 * MiB, WS_WR = 31 * MiB, WS_TAB = 32 * MiB;
constexpr size_t WS_WGU = 36 * MiB, WS_WDN = 164 * MiB, WS_X = 228 * MiB, WS_RSA = 292 * MiB, WS_SSQ = 293 * MiB, WS_G = 295 * MiB, WS_LSE = 296 * MiB;
constexpr size_t WS_S5ST = 299 * MiB, WS_AMEM = 303 * MiB, WS_KMEM = 304 * MiB, WS_VT = 306 * MiB, WS_MISC = 308 * MiB, WS_MST = 312 * MiB;
constexpr size_t WS_P = 346 * MiB, WS_Y = 506 * MiB, WS_OP = 570 * MiB, WS_END = 666 * MiB;
constexpr size_t WS_Q = WS_P, WS_OX = WS_P + 64 * MiB, WS_XS = WS_P, WS_YP = WS_P, WS_H = WS_OP;
constexpr size_t TAB_BIAS = 0, TAB_MLW = 16384, TAB_S5AB = 212992, TAB_S5BB = 262144, TAB_S5CC = 393216, TAB_GLU = 524288, TAB_IMG = 1048576;
constexpr size_t MI_TOKE = 0, MI_TOKP = 262144, MI_TOKG = 524288, MI_TRS = 786432, MI_RT = 1048576, MI_RGATE = 1048576 + 524288, MI_RSS = 2097152, MI_MSC = 2097152 + 524288, MI_MPREV = 3 * 1048576, MI_PTAB = 3 * 1048576 + 65536;
constexpr int CW_TMO = 0, CW_BAR = 4096, CW_ECNT = 8192;
constexpr int RING_OFF = 0, RING_BYTES = 131072, LDSCTL_OFF = RING_BYTES, MISC_OFF = LDSCTL_OFF + 320, TP_OFF = LDSCTL_OFF + 1024;
constexpr int LDS_BYTES = 147456;

#define GAS __attribute__((address_space(1)))
#define LAS __attribute__((address_space(3)))
#define DI __device__ __forceinline__
typedef unsigned short bf16;
typedef unsigned v4u __attribute__((ext_vector_type(4)));
typedef unsigned v2u __attribute__((ext_vector_type(2)));
typedef float f32x4 __attribute__((ext_vector_type(4)));
typedef float f32x2 __attribute__((ext_vector_type(2)));
typedef float f32x16 __attribute__((ext_vector_type(16)));
typedef short bf16x8 __attribute__((ext_vector_type(8)));
typedef short s16x4 __attribute__((ext_vector_type(4)));
typedef GAS unsigned gu32;
#define RLX_AGENT __ATOMIC_RELAXED, __HIP_MEMORY_SCOPE_AGENT
#define LDS_WAIT() asm volatile("s_waitcnt lgkmcnt(0)" ::: "memory")
#define VM_WAIT() asm volatile("s_waitcnt vmcnt(0)" ::: "memory")
#define MFMA32(a, b, c) __builtin_amdgcn_mfma_f32_32x32x16_bf16((a), (b), (c), 0, 0, 0)
#define MFMA16(a, b, c) __builtin_amdgcn_mfma_f32_16x16x32_bf16((a), (b), (c), 0, 0, 0)
using pg8::cvtpk; using pg8::bflo; using pg8::bfhi;
DI unsigned pk2(float lo, float hi) { return cvtpk(lo, hi); }
DI bf16 f2bf(float f) { return (bf16)(cvtpk(f, 0.f) & 0xffffu); }
DI float bf2f(bf16 b) { return __uint_as_float(((unsigned)b) << 16); }
DI bf16x8 pack8(float a0, float a1, float a2, float a3, float a4, float a5, float a6, float a7) { v4u p; p.x = cvtpk(a0, a1); p.y = cvtpk(a2, a3); p.z = cvtpk(a4, a5); p.w = cvtpk(a6, a7); return __builtin_bit_cast(bf16x8, p); }
DI bf16x8 packstep(const f32x16& x, int s) { return s == 0 ? pack8(x[0], x[1], x[2], x[3], x[4], x[5], x[6], x[7]) : pack8(x[8], x[9], x[10], x[11], x[12], x[13], x[14], x[15]); }
DI int crow(int r, int hi) { return (r & 3) + 8 * (r >> 2) + 4 * hi; }
DI void unpack8(const v4u& w, float (&f)[8]) { f[0] = bflo(w.x); f[1] = bfhi(w.x); f[2] = bflo(w.y); f[3] = bfhi(w.y); f[4] = bflo(w.z); f[5] = bfhi(w.z); f[6] = bflo(w.w); f[7] = bfhi(w.w); }
DI float shx(float v, int m, int lane) { return __builtin_bit_cast(float, __builtin_amdgcn_ds_bpermute((lane ^ m) << 2, __builtin_bit_cast(int, v))); }
DI float shl_from(float v, int src) { return __builtin_bit_cast(float, __builtin_amdgcn_ds_bpermute(src << 2, __builtin_bit_cast(int, v))); }
DI float wave_sum(float v, int lane) {
#pragma unroll
    for (int o = 1; o < 64; o <<= 1) v += shx(v, o, lane);
    return v;
}
DI float wave_max(float v, int lane) {
#pragma unroll
    for (int o = 1; o < 64; o <<= 1) v = fmaxf(v, shx(v, o, lane));
    return v;
}
DI s16x4 vtr(const LAS unsigned char* p) { typedef short v4i16_t __attribute__((ext_vector_type(4))); return __builtin_bit_cast(s16x4, __builtin_amdgcn_ds_read_tr16_b64_v4i16((LAS v4i16_t*)p)); }
DI float sigmoidf_(float x) { return 1.0f / (1.0f + __expf(-x)); }
#define XB_TMO      128
#define XB_XCNT(j)  (256  + 64 * (j))
#define XB_XSUB(j)  (1280 + 64 * (j))
#define XB_XGEN(j)  (2304 + 64 * (j))
#define XB_TOP      3328
#define XB_TOPGEN   3392
#define XCD_BAR_WORDS 3456
#define XB_SPIN_CAP (1u << 18)

__device__ __forceinline__ unsigned xb_ld(unsigned* p)              { return __hip_atomic_load(p, __ATOMIC_RELAXED, __HIP_MEMORY_SCOPE_AGENT); }
__device__ __forceinline__ unsigned xb_add(unsigned* p, unsigned v) { return __hip_atomic_fetch_add(p, v, __ATOMIC_RELAXED, __HIP_MEMORY_SCOPE_AGENT); }
__device__ __forceinline__ unsigned xb_xcc_id() { return (unsigned)__builtin_amdgcn_s_getreg((3 << 11) | 20) & 0xFu; }
#define XB_SPIN(cond, bar) do { unsigned _sp = 0; while (cond) { __builtin_amdgcn_s_sleep(1); \
    if ((++_sp & 255u) == 0u) { if (xb_ld(&(bar)[XB_TMO])) break; if (_sp > XB_SPIN_CAP) { atomicAdd(&(bar)[XB_TMO], 1u); break; } } } } while (0)

struct XcdBarrier {
    unsigned* bar; unsigned x;
    volatile LAS unsigned* st;
};

__device__ __forceinline__ XcdBarrier xcd_barrier_post(unsigned* bar, volatile LAS unsigned* st) {
    XcdBarrier b; b.bar = bar; b.x = xb_xcc_id(); b.st = st;
    if (threadIdx.x == 0) (void)xb_add(&bar[XB_XCNT(b.x)], 1u);
    return b;
}
__device__ __forceinline__ void xcd_barrier_complete(unsigned* bar, unsigned x, unsigned& nloc, unsigned& nx) {
    const unsigned G = gridDim.x * gridDim.y * gridDim.z;
    unsigned sum, cnt, mine, sp = 0u;
    for (;;) {
        sum = 0u; cnt = 0u; mine = 0u;
#pragma unroll
        for (unsigned j = 0; j < 16; ++j) { const unsigned c = xb_ld(&bar[XB_XCNT(j)]); sum += c; cnt += (c > 0u) ? 1u : 0u; mine = (j == x) ? c : mine; }
        if (sum == G) break;
        __builtin_amdgcn_s_sleep(1);
        if ((++sp & 255u) == 0u) { if (xb_ld(&bar[XB_TMO])) break; if (sp > XB_SPIN_CAP) { atomicAdd(&bar[XB_TMO], 1u); break; } }
    }
    nloc = mine > 0u ? mine : 1u; nx = cnt > 0u ? cnt : 1u;
}

__device__ __forceinline__ void xcd_barrier(const XcdBarrier& b) {
    asm volatile("s_waitcnt vmcnt(0)" ::: "memory");
    __syncthreads();
    if (threadIdx.x == 0) {
        unsigned* bar = b.bar;
        __builtin_amdgcn_s_waitcnt(0);
        unsigned nloc = b.st[0], nx = b.st[1];
        if (nloc == 0u) { xcd_barrier_complete(bar, b.x, nloc, nx); b.st[0] = nloc; b.st[1] = nx; }
        const unsigned old = xb_add(&bar[XB_XSUB(b.x)], 1u);
        const unsigned gen = old / nloc;
        if (old + 1u == (gen + 1u) * nloc) {
            __builtin_amdgcn_fence(__ATOMIC_RELEASE, "agent");
            asm volatile("s_waitcnt vmcnt(0)" ::: "memory");
            const unsigned og = xb_add(&bar[XB_TOP], 1u);
            const unsigned tg = og / nx;
            if (og + 1u == (tg + 1u) * nx) xb_add(&bar[XB_TOPGEN], 1u);
            else XB_SPIN(xb_ld(&bar[XB_TOPGEN]) == tg, bar);
            __builtin_amdgcn_fence(__ATOMIC_ACQUIRE, "agent");
            xb_add(&bar[XB_XGEN(b.x)], 1u);
            asm volatile("s_waitcnt vmcnt(0)" ::: "memory");
        } else {
            XB_SPIN(xb_ld(&bar[XB_XGEN(b.x)]) == gen, bar);
            __builtin_amdgcn_fence(__ATOMIC_ACQUIRE, "agent");
            asm volatile("s_waitcnt vmcnt(0)" ::: "memory");
        }
    }
    __syncthreads();
}
struct Args { const float* in[39]; float* out; unsigned char* ws; };
enum { I_X = 0, I_MEM, I_REL, I_NMIX, I_WIN, I_CONVW, I_CONVB, I_MWQ, I_MWK, I_MWV, I_MGB, I_MNORM, I_MSKIP, I_S5ARE, I_S5AIM, I_S5DT, I_S5BRE, I_S5BIM, I_S5CRE, I_S5CIM,
       I_S5D, I_S5WGLU, I_S5BGLU, I_S5ONORM, I_AONORM, I_WOUT, I_NXATTN, I_NMEM, I_XWQ, I_XWKV, I_XWO, I_NFFN, I_RWG, I_RBG, I_RWE, I_RBE, I_EWGU, I_EWDN, I_FNORM };

struct Frame {
    LAS unsigned char* lds;
    gu32* ctl;
    int tid, lane, wave, vcu, G;
};

template <class F> DI void tr_item(bf16* WT, int K, LAS float* scr, int kb, int nb, int lane, const F& f) {
    const int k0 = 64 * kb, n0 = 32 * nb, d = n0 + (lane & 31);
    float tv[32];
#pragma unroll
    for (int i = 0; i < 32; ++i) tv[i] = f(k0 + 2 * i + (lane >> 5), d);
#pragma unroll
    for (int i = 0; i < 32; ++i) scr[(2 * i + (lane >> 5)) * 33 + (lane & 31)] = tv[i];
    LDS_WAIT(); asm volatile("" ::: "memory");
    const int c = lane & 7;
#pragma unroll
    for (int j = 0; j < 4; ++j) { const int n = (lane >> 3) + 8 * j; const LAS float* s = scr + (8 * c) * 33 + n;
        v4u o; o.x = pk2(s[0 * 33], s[1 * 33]); o.y = pk2(s[2 * 33], s[3 * 33]); o.z = pk2(s[4 * 33], s[5 * 33]); o.w = pk2(s[6 * 33], s[7 * 33]);
        *(GAS v4u*)(WT + (size_t)(n0 + n) * K + k0 + 8 * c) = o; }
    LDS_WAIT(); asm volatile("" ::: "memory");
}
struct FWin { const float* W; const float* g; DI float operator()(int k, int d) const {
    const int s = d < 512 ? d : (d < 2304 ? d + 8 : (d < 2312 ? d - 2304 + 512 : -1)); if (s < 0) return 0.f;
    const float v = W[(size_t)k * 2312 + s] * g[k]; return (d >= PC_Q && d < PC_K) ? v * (0.125f * 1.4426950408889634f) : v; } };
struct FPlain { const float* W; int ld; DI float operator()(int k, int d) const { return W[(size_t)k * ld + d]; } };
struct FGain { const float* W; int ld; const float* g; float mul; DI float operator()(int k, int d) const { return W[(size_t)k * ld + d] * g[k] * mul; } };
struct FRouter { const float* Wg; const float* We; const float* g; DI float operator()(int k, int d) const { const float v = d < 4 ? Wg[k * 4 + d] : (d < 36 ? We[k * 32 + d - 4] : 0.f); return v * g[k]; } };
struct FMl { const float* W; float mul; DI float operator()(int k, int d) const { return W[k * 64 + d] * mul; } };
struct FGU { const float* W; const float* g; DI float operator()(int k, int d) const { const int s = ((d >> 7) & 1) * 512 + (d >> 8) * 128 + (d & 127); return W[(size_t)k * 1024 + s] * g[k]; } };

DI void p0_prologue(Frame& F, const Args& A) {
    unsigned char* ws = A.ws;
    LAS float* scr = (LAS float*)(F.lds + RING_OFF + F.wave * 16384);
    const int gw = F.vcu * NWAVES + F.wave, NGW = F.G * NWAVES, lane = F.lane;
    constexpr int I_IN = 16 * 80, I_SQ = 16 * 32, I_KV = 16 * 64, I_RT = 16 * 2, I_GU = 32 * 512, I_DN = 32 * 256, I_ML = 24, I_GL = 32;
    constexpr int PER_L = I_IN + 3 * I_SQ + I_KV + I_RT + I_GU + I_DN + I_ML + I_GL;
    for (int it = gw; it < NLAYER * PER_L; it += NGW) {
        const int l = it / PER_L; int r = it % PER_L;
        if (r < I_IN) { FWin f{A.in[I_WIN] + (size_t)l * 1024 * 2312, A.in[I_NMIX] + l * 1024}; tr_item((bf16*)(ws + WS_WIN) + (size_t)l * 2560 * 1024, 1024, scr, r / 80, r % 80, lane, f); continue; } r -= I_IN;
        if (r < I_SQ) { FPlain f{A.in[I_WOUT] + (size_t)l * 1048576, 1024}; tr_item((bf16*)(ws + WS_WOUT) + (size_t)l * 1048576, 1024, scr, r / 32, r % 32, lane, f); continue; } r -= I_SQ;
        if (r < I_SQ) { FGain f{A.in[I_XWQ] + (size_t)l * 1048576, 1024, A.in[I_NXATTN] + l * 1024, 0.0625f}; tr_item((bf16*)(ws + WS_WQ) + (size_t)l * 1048576, 1024, scr, r / 32, r % 32, lane, f); continue; } r -= I_SQ;
        if (r < I_SQ) { FPlain f{A.in[I_XWO] + (size_t)l * 1048576, 1024}; tr_item((bf16*)(ws + WS_WO) + (size_t)l * 1048576, 1024, scr, r / 32, r % 32, lane, f); continue; } r -= I_SQ;
        if (r < I_KV) { FGain f{A.in[I_XWKV] + (size_t)l * 2097152, 2048, A.in[I_NMEM] + l * 1024, 1.0f}; tr_item((bf16*)(ws + WS_WKV) + (size_t)l * 2097152, 1024, scr, r / 64, r % 64, lane, f); continue; } r -= I_KV;
        if (r < I_RT) { FRouter f{A.in[I_RWG] + l * 4096, A.in[I_RWE] + l * 32768, A.in[I_NFFN] + l * 1024}; tr_item((bf16*)(ws + WS_WR) + (size_t)l * 65536, 1024, scr, r / 2, r % 2, lane, f); continue; } r -= I_RT;
        if (r < I_GU) { const int e = r / 512, q = r % 512; FGU f{A.in[I_EWGU] + ((size_t)l * 32 + e) * 1048576, A.in[I_NFFN] + l * 1024};
            tr_item((bf16*)(ws + WS_WGU) + ((size_t)l * 32 + e) * 1048576, 1024, scr, q / 32, q % 32, lane, f); continue; } r -= I_GU;
        if (r < I_DN) { const int e = r / 256, q = r % 256; FPlain f{A.in[I_EWDN] + ((size_t)l * 32 + e) * 524288, 1024};
            tr_item((bf16*)(ws + WS_WDN) + ((size_t)l * 32 + e) * 524288, 512, scr, q / 32, q % 32, lane, f); continue; } r -= I_DN;
        if (r < I_ML) { const int h = r / 6, which = (r % 6) / 2, nb = r % 2;
            const float* src = A.in[which == 0 ? I_MWQ : (which == 1 ? I_MWK : I_MWV)] + ((size_t)l * 4 + h) * 4096;
            FMl fm{src, which == 0 ? 0.125f : 1.0f};
            tr_item((bf16*)(ws + WS_TAB + TAB_MLW) + (((size_t)l * 4 + h) * 3 + which) * 4096, 64, scr, 0, nb, lane, fm); continue; } r -= I_ML;
        { FPlain f{A.in[I_S5WGLU] + (size_t)l * 65536, 256}; tr_item((bf16*)(ws + WS_TAB + TAB_GLU) + (size_t)l * 65536, 256, scr, r / 8, r % 8, lane, f); }
    }
    for (int m = gw; m < T + 512; m += NGW) {
        const bool ismem = m >= T; const float* src = ismem ? A.in[I_MEM] + (size_t)(m - T) * D : A.in[I_X] + (size_t)m * D;
        const GAS f32x4* xr = (const GAS f32x4*)src + lane;
        f32x4 v[4]; float s = 0.f;
#pragma unroll
        for (int j = 0; j < 4; ++j) { v[j] = xr[64 * j]; s += (v[j].x * v[j].x + v[j].y * v[j].y) + (v[j].z * v[j].z + v[j].w * v[j].w); }
        const float rs = 1.0f / sqrtf(wave_sum(s, lane) * (1.0f / D) + RMS_EPS); const float mul = ismem ? rs : 1.0f;
        bf16* dst = ismem ? (bf16*)(ws + WS_AMEM) + (size_t)(m - T) * D : (bf16*)(ws + WS_X) + (size_t)m * D;
        GAS v2u* o8 = (GAS v2u*)dst + lane;
#pragma unroll
        for (int j = 0; j < 4; ++j) { v2u w; w.x = pk2(v[j].x * mul, v[j].y * mul); w.y = pk2(v[j].z * mul, v[j].w * mul); o8[64 * j] = w; }
        if (!ismem && lane == 0) ((float*)(ws + WS_RSA))[m] = rs;
    }
    const int gt = F.vcu * NWAVES * 64 + F.tid, NGT = F.G * NWAVES * 64;
    for (int i = gt; i < 3 * 8 * 132; i += NGT) { const int p = i / (8 * 132), h = (i / 132) % 8, off = i % 132; const int dist = off * (p == 0 ? 1 : (p == 1 ? 4 : 16));
        int bk = dist; if (dist >= 16) { bk = 16 + (int)(log((double)dist / 16.0) / log(2048.0 / 16.0) * 16.0); bk = bk < 31 ? bk : 31; }
        ((float*)(ws + WS_TAB + TAB_BIAS))[i] = A.in[I_REL][bk * 8 + h]; }
    for (int i = gt; i < 3 * 8 * 5 * 64 * 16; i += NGT) { const int ph = i / 5120, rem = i % 5120, j = rem / 1024, ln = (rem >> 4) & 63, ri = rem & 15; const int p = ph >> 3, h = ph & 7;
        const int off = 128 - 32 * j + (ln & 31) - crow(ri, ln >> 5); float v = -1.0e30f;
        if (off >= 0 && off <= 128) { const int dist = off * (p == 0 ? 1 : (p == 1 ? 4 : 16)); int bk = dist; if (dist >= 16) { bk = 16 + (int)(log((double)dist / 16.0) / log(2048.0 / 16.0) * 16.0); bk = bk < 31 ? bk : 31; }
            v = A.in[I_REL][bk * 8 + h] * 1.4426950408889634f; }
        ((float*)(ws + WS_TAB + TAB_IMG))[i] = v; }
    for (int i = gt; i < NLAYER * 16 * 64; i += NGT) {
        const int l = i / 1024, g = (i / 64) % 16, p = i % 64;
        const float are = A.in[I_S5ARE][i], aim = A.in[I_S5AIM][i], dt = expf(A.in[I_S5DT][l * 16 + g]);
        const float mag = expf(are * dt); const float abr = mag * cosf(aim * dt), abi = mag * sinf(aim * dt);
        float* ab = (float*)(ws + WS_TAB + TAB_S5AB) + (size_t)i * 6; ab[0] = abr; ab[1] = abi;
        float pr = abr, pi = abi;
#pragma unroll 1
        for (int k = 0; k < 6; ++k) { float nr = pr * pr; asm volatile("" : "+v"(nr)); nr = __builtin_fmaf(-pi, pi, nr); asm volatile("" : "+v"(nr)); float ni = 2.f * pr * pi; asm volatile("" : "+v"(ni)); pr = nr; pi = ni; if (k == 1) { ab[2] = pr; ab[3] = pi; } }
        ab[4] = pr; ab[5] = pi;
        const float den = are * are + aim * aim, xr = abr - 1.0f, yi = abi;
        float cre = xr * are; asm volatile("" : "+v"(cre)); cre = __builtin_fmaf(yi, aim, cre) / den; asm volatile("" : "+v"(cre)); float cim = yi * are; asm volatile("" : "+v"(cim)); cim = __builtin_fmaf(-xr, aim, cim) / den; asm volatile("" : "+v"(cim));
        bf16* bb = (bf16*)(ws + WS_TAB + TAB_S5BB) + ((size_t)(l * 16 + g) * 128) * 16; bf16* cc = (bf16*)(ws + WS_TAB + TAB_S5CC) + ((size_t)(l * 16 + g) * 16) * 128;
        for (int h = 0; h < 16; ++h) {
            const float bre = A.in[I_S5BRE][(size_t)i * 16 + h], bim = A.in[I_S5BIM][(size_t)i * 16 + h];
            float v0 = cre * bre; asm volatile("" : "+v"(v0)); v0 = __builtin_fmaf(-cim, bim, v0); asm volatile("" : "+v"(v0)); float v1 = cre * bim; asm volatile("" : "+v"(v1)); v1 = __builtin_fmaf(cim, bre, v1); asm volatile("" : "+v"(v1));
            bb[(size_t)p * 16 + h] = f2bf(v0); bb[(size_t)(64 + p) * 16 + h] = f2bf(v1);
            const size_t ci = ((size_t)(l * 16 + g) * 16 + h) * 64 + p;
            cc[(size_t)h * 128 + 2 * p] = f2bf(A.in[I_S5CRE][ci]); cc[(size_t)h * 128 + 2 * p + 1] = f2bf(-A.in[I_S5CIM][ci]);
        }
    }
}
constexpr int VST_PITCH = 144;
DI void dil_attn_task(const bf16* __restrict__ P, bf16* __restrict__ OPp, float* __restrict__ LSEp, const LAS float* img  , LAS unsigned char* vst, int dil, int b, int h, int r, int qt, int lane) {
    asm volatile("" : "+v"(lane));
    const int l31 = lane & 31, hh = lane >> 5;
    const int qi = 32 * qt + l31;
    const size_t rowb = (size_t)b * SEQ;
    const bf16* qp = P + (rowb + (size_t)qi * dil + r) * PW + PC_Q + h * 64 + 8 * hh;
    bf16x8 qf[4];
#pragma unroll
    for (int ks = 0; ks < 4; ++ks) qf[ks] = *(const bf16x8*)(qp + 16 * ks);
    bf16x8 kf[5][4]; v4u vv[5][4];
#pragma unroll
    for (int j = 0; j < 5; ++j) {
        const int kb = 32 * (qt - 4 + j); int ki = kb + l31; ki = ki < 0 ? 0 : ki;
        const bf16* kp = P + (rowb + (size_t)ki * dil + r) * PW + PC_K + h * 64 + 8 * hh;
#pragma unroll
        for (int ks = 0; ks < 4; ++ks) kf[j][ks] = *(const bf16x8*)(kp + 16 * ks);
    }
#pragma unroll
    for (int j = 0; j < 5; ++j) {
        const int kb = 32 * (qt - 4 + j);
#pragma unroll
        for (int k = 0; k < 4; ++k) { const int piece = lane + 64 * k, rr = piece >> 3, ch = piece & 7; int ki = kb + rr; ki = ki < 0 ? 0 : ki;
            vv[j][k] = *(const v4u*)(P + (rowb + (size_t)ki * dil + r) * PW + PC_V + h * 64 + ch * 8); }
    }
    f32x16 s[5];
    float m = -3.0e38f;
#pragma unroll
    for (int j = 0; j < 5; ++j) {
        const LAS f32x4* ip = (const LAS f32x4*)(img + (j * 64 + lane) * 16);
        const f32x4 c0 = ip[0], c1 = ip[1], c2 = ip[2], c3 = ip[3];
        f32x16 a = {c0[0], c0[1], c0[2], c0[3], c1[0], c1[1], c1[2], c1[3], c2[0], c2[1], c2[2], c2[3], c3[0], c3[1], c3[2], c3[3]};
#pragma unroll
        for (int ks = 0; ks < 4; ++ks) a = MFMA32(kf[j][ks], qf[ks], a);
        if (qt - 4 + j < 0) {
#pragma unroll
            for (int i = 0; i < 16; ++i) a[i] = -1.0e30f;
        }
#pragma unroll
        for (int i = 0; i < 16; ++i) m = fmaxf(m, a[i]);
        s[j] = a;
    }
    m = fmaxf(m, shx(m, 32, lane));
    float lsum = 0.f;
#pragma unroll
    for (int j = 0; j < 5; ++j)
#pragma unroll
        for (int i = 0; i < 16; ++i) { const float p = __builtin_amdgcn_exp2f(s[j][i] - m); s[j][i] = p; lsum += p; }
    lsum += shx(lsum, 32, lane);
    const float inv = 1.0f / lsum;
    if (hh == 0) LSEp[(rowb + (size_t)qi * dil + r) * 8 + h] = m + __log2f(lsum);
    f32x16 o[2];
#pragma unroll
    for (int nt = 0; nt < 2; ++nt) o[nt] = (f32x16){0.f, 0.f, 0.f, 0.f, 0.f, 0.f, 0.f, 0.f, 0.f, 0.f, 0.f, 0.f, 0.f, 0.f, 0.f, 0.f};
    const int i16 = lane & 15, q4 = i16 >> 2, p4 = i16 & 3, blk = (lane >> 4) & 1;
#pragma unroll
    for (int j = 0; j < 5; ++j) {
#pragma unroll
        for (int k = 0; k < 4; ++k) { const int piece = lane + 64 * k, rr = piece >> 3, ch = piece & 7; *(LAS v4u*)(vst + rr * VST_PITCH + ch * 16) = vv[j][k]; }
#pragma unroll
        for (int st = 0; st < 2; ++st) {
            bf16x8 af;
            { const f32x16& x = s[j]; af = st == 0 ? pack8(x[0] * inv, x[1] * inv, x[2] * inv, x[3] * inv, x[4] * inv, x[5] * inv, x[6] * inv, x[7] * inv)
                                                  : pack8(x[8] * inv, x[9] * inv, x[10] * inv, x[11] * inv, x[12] * inv, x[13] * inv, x[14] * inv, x[15] * inv); }
#pragma unroll
            for (int nt = 0; nt < 2; ++nt) {
                const LAS unsigned char* a0 = vst + (16 * st + 4 * hh + q4) * VST_PITCH + (32 * nt + 16 * blk + 4 * p4) * 2;
                const s16x4 lo = vtr(a0), hi = vtr(a0 + 8 * VST_PITCH);
                const bf16x8 bfr = (bf16x8){lo[0], lo[1], lo[2], lo[3], hi[0], hi[1], hi[2], hi[3]};
                o[nt] = MFMA32(af, bfr, o[nt]);
            }
        }
    }
#pragma unroll
    for (int i = 0; i < 16; ++i) { const int qq = 32 * qt + crow(i, hh); bf16* op = OPp + (rowb + (size_t)qq * dil + r) * 512 + h * 64 + l31;
        op[0] = f2bf(o[0][i]); op[32] = f2bf(o[1][i]); }
}

DI void mlstm_cu_frags(const bf16* __restrict__ P, const LAS float* cw  , size_t row0  , int tchunk0  , int h, int lane,
                       bf16x8 (&cf)[2][4], bf16x8 (&uf)[2][4]) {
    const int l31 = lane & 31, hh = lane >> 5;
#pragma unroll
    for (int tt = 0; tt < 2; ++tt)
#pragma unroll
        for (int ks = 0; ks < 4; ++ks) {
            const int tok = 32 * tt + l31, ch = h * 64 + 16 * ks + 8 * hh; const int pos = tchunk0 + tok;
            const bf16* up = P + (row0 + tok) * PW + PC_MU + ch;
            float acc[8];
            { const f32x4 b0 = *(const LAS f32x4*)(cw + 1024 + ch), b1 = *(const LAS f32x4*)(cw + 1024 + ch + 4); acc[0] = b0[0]; acc[1] = b0[1]; acc[2] = b0[2]; acc[3] = b0[3]; acc[4] = b1[0]; acc[5] = b1[1]; acc[6] = b1[2]; acc[7] = b1[3]; }
#pragma unroll
            for (int tap = 0; tap < 4; ++tap) {
                const int back = 3 - tap; const bool ok = pos - back >= 0;
                v4u w = *(const v4u*)(up - (ok ? (size_t)back * PW : 0));
                if (!ok) w = (v4u){0u, 0u, 0u, 0u};
                if (tap == 3) uf[tt][ks] = __builtin_bit_cast(bf16x8, w);
                float f[8]; unpack8(w, f);
                const f32x4 w0 = *(const LAS f32x4*)(cw + tap * 256 + ch), w1 = *(const LAS f32x4*)(cw + tap * 256 + ch + 4);
                acc[0] += w0[0] * f[0]; acc[1] += w0[1] * f[1]; acc[2] += w0[2] * f[2]; acc[3] += w0[3] * f[3]; acc[4] += w1[0] * f[4]; acc[5] += w1[1] * f[5]; acc[6] += w1[2] * f[6]; acc[7] += w1[3] * f[7];
            }
#pragma unroll
            for (int e = 0; e < 8; ++e) acc[e] = acc[e] * sigmoidf_(acc[e]);
            cf[tt][ks] = pack8(acc[0], acc[1], acc[2], acc[3], acc[4], acc[5], acc[6], acc[7]);
            asm volatile("" : "+v"(cf[tt][ks]), "+v"(uf[tt][ks]));
        }
}
DI float log_sigmoid_(float x) { const float e = __expf(-fabsf(x)); return fminf(x, 0.f) - __logf(1.0f + e); }
DI float wave_incl_scan(float v, int lane) {
#pragma unroll
    for (int o = 1; o < 64; o <<= 1) { const float t = shl_from(v, lane - o); if (lane >= o) v += t; }
    return v;
}
DI void mlstm_b1_task(const bf16* __restrict__ P, const float* __restrict__ G, const bf16* __restrict__ mlw  , const float* __restrict__ gb  ,
                      const LAS float* cw, LAS float* wsc  , float* __restrict__ MST, float* __restrict__ MSC, int b, int c, int h, int lane) {
    asm volatile("" : "+v"(lane));
    const int l31 = lane & 31, hh = lane >> 5;
    const size_t row0 = (size_t)b * SEQ + (size_t)c * 64;
    bf16x8 cf[2][4], uf[2][4];
    mlstm_cu_frags(P, cw, row0, c * 64, h, lane, cf, uf);
    const float li = G[(row0 + lane) * 8 + h] + gb[h];
    const float lf = log_sigmoid_(G[(row0 + lane) * 8 + 4 + h] + gb[4 + h]);
    const float bcs = wave_incl_scan(lf, lane);
    const float gtot = __builtin_bit_cast(float, __builtin_amdgcn_readlane(__builtin_bit_cast(int, bcs), 63));
    const float a = gtot - bcs + li;
    const float amax = wave_max(a, lane);
    wsc[lane] = __expf(a - amax);
    LDS_WAIT();
    const bf16* wk = mlw + ((size_t)h * 3 + 1) * 4096, * wv = mlw + ((size_t)h * 3 + 2) * 4096;
    const f32x16 z16 = {0.f, 0.f, 0.f, 0.f, 0.f, 0.f, 0.f, 0.f, 0.f, 0.f, 0.f, 0.f, 0.f, 0.f, 0.f, 0.f};
    float* st = MST + ((size_t)(b * 4 + h) * 256 + c) * 4160;
    bf16x8 kpk[2][2][2];
    {
        f32x16 kacc[2][2] = {{z16, z16}, {z16, z16}};
#pragma unroll
        for (int ks = 0; ks < 4; ++ks)
#pragma unroll
            for (int nt = 0; nt < 2; ++nt) { const bf16x8 bk = *(const bf16x8*)(wk + (32 * nt + l31) * 64 + 16 * ks + 8 * hh);
#pragma unroll
                for (int tt = 0; tt < 2; ++tt) kacc[tt][nt] = MFMA32(cf[tt][ks], bk, kacc[tt][nt]); }
        float nsum[2] = {0.f, 0.f};
#pragma unroll
        for (int tt = 0; tt < 2; ++tt)
#pragma unroll
            for (int i = 0; i < 16; ++i) { const float w = wsc[32 * tt + crow(i, hh)];
#pragma unroll
                for (int nt = 0; nt < 2; ++nt) { kacc[tt][nt][i] *= w; nsum[nt] += kacc[tt][nt][i]; } }
#pragma unroll
        for (int nt = 0; nt < 2; ++nt) { nsum[nt] += shx(nsum[nt], 32, lane); if (hh == 0) st[4096 + 32 * nt + l31] = nsum[nt]; }
#pragma unroll
        for (int tt = 0; tt < 2; ++tt)
#pragma unroll
            for (int nt = 0; nt < 2; ++nt) { kpk[tt][nt][0] = packstep(kacc[tt][nt], 0); kpk[tt][nt][1] = packstep(kacc[tt][nt], 1); }
    }
    __builtin_amdgcn_sched_barrier(0);
#pragma unroll
    for (int et = 0; et < 2; ++et) {
        f32x16 va[2] = {z16, z16};
#pragma unroll
        for (int ks = 0; ks < 4; ++ks) { const bf16x8 bv = *(const bf16x8*)(wv + (32 * et + l31) * 64 + 16 * ks + 8 * hh);
#pragma unroll
            for (int tt = 0; tt < 2; ++tt) va[tt] = MFMA32(uf[tt][ks], bv, va[tt]); }
        const bf16x8 v00 = packstep(va[0], 0), v01 = packstep(va[0], 1), v10 = packstep(va[1], 0), v11 = packstep(va[1], 1);
#pragma unroll
        for (int dt = 0; dt < 2; ++dt) {
            f32x16 u = z16;
            u = MFMA32(v00, kpk[0][dt][0], u); u = MFMA32(v01, kpk[0][dt][1], u); u = MFMA32(v10, kpk[1][dt][0], u); u = MFMA32(v11, kpk[1][dt][1], u);
#pragma unroll
            for (int i = 0; i < 16; ++i) st[(32 * et + crow(i, hh)) * 64 + 32 * dt + l31] = u[i];
        }
        __builtin_amdgcn_sched_barrier(0);
    }
    if (lane == 0) { MSC[((size_t)(b * 4 + h) * 256 + c) * 2] = gtot; MSC[((size_t)(b * 4 + h) * 256 + c) * 2 + 1] = amax; }
}

#define CSTEP(nr, ni, ar_, ai_, xr_, xi_, br_, bi_) do { nr = __builtin_fmaf((ar_), (xr_), (br_)); asm volatile("" : "+v"(nr)); nr = __builtin_fmaf(-(ai_), (xi_), nr); asm volatile("" : "+v"(nr)); \
    ni = __builtin_fmaf((ar_), (xi_), (bi_)); asm volatile("" : "+v"(ni)); ni = __builtin_fmaf((ai_), (xr_), ni); asm volatile("" : "+v"(ni)); } while (0)
DI void s5_bu(const bf16* __restrict__ P, const bf16* __restrict__ bb  , size_t row0, int g, int lane, f32x16 (&acc)[2][4]) {
    const int l31 = lane & 31, hh = lane >> 5;
    bf16x8 af[2], bfr[4];
#pragma unroll
    for (int tt = 0; tt < 2; ++tt) af[tt] = *(const bf16x8*)(P + (row0 + 32 * tt + l31) * PW + PC_SU + g * 16 + 8 * hh);
#pragma unroll
    for (int nt = 0; nt < 4; ++nt) bfr[nt] = *(const bf16x8*)(bb + (32 * nt + l31) * 16 + 8 * hh);
#pragma unroll
    for (int tt = 0; tt < 2; ++tt)
#pragma unroll
        for (int nt = 0; nt < 4; ++nt) acc[tt][nt] = MFMA32(af[tt], bfr[nt], ((f32x16){0.f, 0.f, 0.f, 0.f, 0.f, 0.f, 0.f, 0.f, 0.f, 0.f, 0.f, 0.f, 0.f, 0.f, 0.f, 0.f}));
}
DI void s5_end_task(const bf16* __restrict__ P, const bf16* __restrict__ bb, const float* __restrict__ ab  , float* __restrict__ S5ST, int b, int c, int g, int lane) {
    asm volatile("" : "+v"(lane));
    const int l31 = lane & 31, hh = lane >> 5;
    const size_t row0 = (size_t)b * SEQ + (size_t)c * 64;
    f32x16 acc[2][4];
    s5_bu(P, bb, row0, g, lane, acc);
#pragma unroll
    for (int pt = 0; pt < 2; ++pt) {
        const float* abp = ab + (32 * pt + l31) * 6; const float ar = abp[0], ai = abp[1], a4r = abp[2], a4i = abp[3];
        const float prr = hh ? a4r : 1.f, pri = hh ? a4i : 0.f, por = hh ? 1.f : a4r, poi = hh ? 0.f : a4i;
        float xr = 0.f, xi = 0.f;
#pragma unroll
        for (int tt = 0; tt < 2; ++tt)
#pragma unroll
            for (int q4 = 0; q4 < 4; ++q4) {
                { float nr, ni; CSTEP(nr, ni, prr, pri, xr, xi, 0.f, 0.f); xr = nr; xi = ni; }
#pragma unroll
                for (int j = 0; j < 4; ++j) { float nr, ni; CSTEP(nr, ni, ar, ai, xr, xi, acc[tt][pt][4 * q4 + j], acc[tt][2 + pt][4 * q4 + j]); xr = nr; xi = ni; }
                { float nr, ni; CSTEP(nr, ni, por, poi, xr, xi, 0.f, 0.f); xr = nr; xi = ni; }
            }
        xr += shx(xr, 32, lane); xi += shx(xi, 32, lane);
        if (DBG_S5_SYNTH) { xr = 0.01f * (float)((c + l31 + g) & 15); xi = -0.005f * (float)((c + pt) & 7); }
        if (hh == 0) { f32x2 v = {xr, xi}; *(f32x2*)(S5ST + ((((size_t)b * 256 + c) * 16 + g) * 64 + 32 * pt + l31) * 2) = v; }
    }
}
DI void mlstm_scan_task(float* __restrict__ MST, const float* __restrict__ MSC, float* __restrict__ MPREV, int wt  , int lane) {
    asm volatile("" : "+v"(lane));
    const int e = wt * 64 + lane; const int bh = e / 4160, el = e % 4160;
    float* st = MST + (size_t)bh * 256 * 4160 + el; const float* sc = MSC + (size_t)bh * 512;
    float m = 0.f, C = 0.f;
    float ua[16], ub[16];
#pragma unroll
    for (int k = 0; k < 16; ++k) ua[k] = st[(size_t)k * 4160];
#pragma unroll 1
    for (int c0 = 0; c0 < 256; c0 += 32) {
#pragma unroll
        for (int k = 0; k < 16; ++k) ub[k] = st[(size_t)(c0 + 16 + k) * 4160];
#pragma unroll
        for (int k = 0; k < 16; ++k) {
            const float g = sc[(c0 + k) * 2], amax = sc[(c0 + k) * 2 + 1];
            const float mn = fmaxf(g + m, amax); const float dec = __expf(g + m - mn), scl = __expf(amax - mn);
            st[(size_t)(c0 + k) * 4160] = C; if (el == 0) MPREV[bh * 256 + c0 + k] = m;
            C = dec * C + scl * ua[k]; m = mn;
        }
        if (c0 + 32 < 256) {
#pragma unroll
            for (int k = 0; k < 16; ++k) ua[k] = st[(size_t)(c0 + 32 + k) * 4160];
        }
#pragma unroll
        for (int k = 0; k < 16; ++k) {
            const float g = sc[(c0 + 16 + k) * 2], amax = sc[(c0 + 16 + k) * 2 + 1];
            const float mn = fmaxf(g + m, amax); const float dec = __expf(g + m - mn), scl = __expf(amax - mn);
            st[(size_t)(c0 + 16 + k) * 4160] = C; if (el == 0) MPREV[bh * 256 + c0 + 16 + k] = m;
            C = dec * C + scl * ub[k]; m = mn;
        }
    }
}
DI void s5_scan_task(float* __restrict__ S5ST, const float* __restrict__ ab  , int wt  , int lane) {
    asm volatile("" : "+v"(lane));
    const int e = wt * 64 + lane; const int b = e >> 10, gp = e & 1023;
    const float a64r = ab[gp * 6 + 4], a64i = ab[gp * 6 + 5];
    float* st = S5ST + ((size_t)b * 256 * 1024 + gp) * 2;
    float xr = 0.f, xi = 0.f;
    f32x2 ua[16], ub[16];
#pragma unroll
    for (int k = 0; k < 16; ++k) ua[k] = *(const f32x2*)(st + (size_t)k * 2048);
#pragma unroll 1
    for (int c0 = 0; c0 < 256; c0 += 32) {
#pragma unroll
        for (int k = 0; k < 16; ++k) ub[k] = *(const f32x2*)(st + (size_t)(c0 + 16 + k) * 2048);
#pragma unroll
        for (int k = 0; k < 16; ++k) { f32x2 o = {xr, xi}; *(f32x2*)(st + (size_t)(c0 + k) * 2048) = o;
            float nr, ni; CSTEP(nr, ni, a64r, a64i, xr, xi, ua[k].x, ua[k].y); xr = nr; xi = ni; }
        if (c0 + 32 < 256) {
#pragma unroll
            for (int k = 0; k < 16; ++k) ua[k] = *(const f32x2*)(st + (size_t)(c0 + 32 + k) * 2048);
        }
#pragma unroll
        for (int k = 0; k < 16; ++k) { f32x2 o = {xr, xi}; *(f32x2*)(st + (size_t)(c0 + 16 + k) * 2048) = o;
            float nr, ni; CSTEP(nr, ni, a64r, a64i, xr, xi, ub[k].x, ub[k].y); xr = nr; xi = ni; }
    }
}

DI void mlstm_b3_task(const bf16* __restrict__ P, const float* __restrict__ G, const bf16* __restrict__ mlw, const float* __restrict__ gb, const float* __restrict__ mnorm  , const float* __restrict__ mskip  ,
                      const LAS float* cw, LAS float* wsc  , LAS unsigned char* hst  , const float* __restrict__ MST, const float* __restrict__ MPREV,
                      bf16* __restrict__ Y, int b, int c, int h, int lane) {
    asm volatile("" : "+v"(lane));
    const int l31 = lane & 31, hh = lane >> 5;
    const size_t row0 = (size_t)b * SEQ + (size_t)c * 64;
    bf16x8 cf[2][4], uf[2][4];
    mlstm_cu_frags(P, cw, row0, c * 64, h, lane, cf, uf);
    const float li = G[(row0 + lane) * 8 + h] + gb[h];
    const float lf = log_sigmoid_(G[(row0 + lane) * 8 + 4 + h] + gb[4 + h]);
    const float bcs = wave_incl_scan(lf, lane);
    const float mprev = MPREV[(b * 4 + h) * 256 + c];
    const float* st = MST + ((size_t)(b * 4 + h) * 256 + c) * 4160;
    wsc[lane] = bcs; wsc[64 + lane] = li - bcs; wsc[128 + lane] = st[4096 + lane];
    LDS_WAIT();
    float bl[2], mt[2], inter[2];
#pragma unroll
    for (int lt = 0; lt < 2; ++lt) {
        const int l = 32 * lt + l31; bl[lt] = wsc[l]; float mx = -3.0e38f;
#pragma unroll 8
        for (int s = 0; s < 64; ++s) { const float v = wsc[64 + s]; mx = (s <= l) ? fmaxf(mx, v) : mx; }
        const float mi = bl[lt] + mprev; mt[lt] = fmaxf(mi, bl[lt] + mx); inter[lt] = __expf(mi - mt[lt]);
    }
    const bf16* wq = mlw + ((size_t)h * 3 + 0) * 4096, * wk = mlw + ((size_t)h * 3 + 1) * 4096, * wv = mlw + ((size_t)h * 3 + 2) * 4096;
    const f32x16 z16 = {0.f, 0.f, 0.f, 0.f, 0.f, 0.f, 0.f, 0.f, 0.f, 0.f, 0.f, 0.f, 0.f, 0.f, 0.f, 0.f};
    __builtin_amdgcn_sched_barrier(0);
#pragma unroll
    for (int lt = 0; lt < 2; ++lt) {
        const int l = 32 * lt + l31;
        asm volatile("" ::: "memory");
        bf16x8 qp[2][2], qsp[2][2]; float dq = 0.f;
#pragma unroll
        for (int dt = 0; dt < 2; ++dt) {
            f32x16 qa = z16;
#pragma unroll
            for (int ks = 0; ks < 4; ++ks) { const bf16x8 aq = *(const bf16x8*)(wq + (32 * dt + l31) * 64 + 16 * ks + 8 * hh); qa = MFMA32(aq, cf[lt][ks], qa); }
            qp[dt][0] = packstep(qa, 0); qp[dt][1] = packstep(qa, 1);
            f32x16 qs = qa * inter[lt];
#pragma unroll
            for (int i = 0; i < 16; ++i) dq += qs[i] * wsc[128 + 32 * dt + crow(i, hh)];
            qsp[dt][0] = packstep(qs, 0); qsp[dt][1] = packstep(qs, 1);
            asm volatile("" : "+v"(qp[dt][0]), "+v"(qp[dt][1]), "+v"(qsp[dt][0]), "+v"(qsp[dt][1]), "+v"(dq));
        }
        asm volatile("" ::: "memory");
        f32x16 oacc[2] = {z16, z16};
#pragma unroll
        for (int et = 0; et < 2; ++et)
#pragma unroll
            for (int dt = 0; dt < 2; ++dt)
#pragma unroll
                for (int sp = 0; sp < 2; ++sp) {
                    const float* cp = st + (size_t)(32 * et + l31) * 64 + 32 * dt + 16 * sp + 4 * hh;
                    const f32x4 c0 = *(const f32x4*)cp, c1 = *(const f32x4*)(cp + 8);
                    oacc[et] = MFMA32(pack8(c0[0], c0[1], c0[2], c0[3], c1[0], c1[1], c1[2], c1[3]), qsp[dt][sp], oacc[et]);
                }
        asm volatile("" : "+v"(oacc[0]), "+v"(oacc[1]) :: "memory");
        float rsum = 0.f;
#pragma unroll
        for (int stl = 0; stl < 2; ++stl) {
            if (stl > lt) continue;
            asm volatile("" ::: "memory");
            f32x16 sacc = z16;
#pragma unroll
            for (int dt = 0; dt < 2; ++dt) {
                f32x16 ka = z16;
#pragma unroll
                for (int ks = 0; ks < 4; ++ks) { const bf16x8 ak = *(const bf16x8*)(wk + (32 * dt + l31) * 64 + 16 * ks + 8 * hh); ka = MFMA32(ak, cf[stl][ks], ka); }
                sacc = MFMA32(packstep(ka, 0), qp[dt][0], sacc); sacc = MFMA32(packstep(ka, 1), qp[dt][1], sacc);
            }
#pragma unroll
            for (int i = 0; i < 16; ++i) { const int s = 32 * stl + crow(i, hh); const float dm = bl[lt] + wsc[64 + s] - mt[lt];
                const float w = (s <= l) ? __expf(dm) * sacc[i] : 0.f; sacc[i] = w; rsum += w; }
            bf16x8 w0 = packstep(sacc, 0), w1 = packstep(sacc, 1);
            asm volatile("" : "+v"(w0), "+v"(w1), "+v"(rsum) :: "memory");
#pragma unroll
            for (int et = 0; et < 2; ++et) {
                f32x16 va = z16;
#pragma unroll
                for (int ks = 0; ks < 4; ++ks) { const bf16x8 bv = *(const bf16x8*)(wv + (32 * et + l31) * 64 + 16 * ks + 8 * hh);
                    const bf16x8 ua = *(const bf16x8*)(P + (row0 + 32 * stl + l31) * PW + PC_MU + h * 64 + 16 * ks + 8 * hh); va = MFMA32(ua, bv, va); }
                oacc[et] = MFMA32(packstep(va, 0), w0, oacc[et]); oacc[et] = MFMA32(packstep(va, 1), w1, oacc[et]);
                asm volatile("" ::: "memory");
            }
        }
        float den = dq + rsum; den += shx(den, 32, lane);
        const float dn = fmaxf(fabsf(den), __expf(-mt[lt])); const float rd = 1.0f / dn;
        float ss = 0.f;
#pragma unroll
        for (int et = 0; et < 2; ++et)
#pragma unroll
            for (int i = 0; i < 16; ++i) { const float hv = oacc[et][i] * rd; oacc[et][i] = hv; ss += hv * hv; }
        ss += shx(ss, 32, lane);
        const float rn = 1.0f / sqrtf(ss * (1.0f / 64.0f) + RMS_EPS);
#pragma unroll
        for (int et = 0; et < 2; ++et)
#pragma unroll
            for (int g4 = 0; g4 < 4; ++g4) { v2u w; w.x = pk2(oacc[et][4 * g4] * rn, oacc[et][4 * g4 + 1] * rn); w.y = pk2(oacc[et][4 * g4 + 2] * rn, oacc[et][4 * g4 + 3] * rn);
                *(LAS v2u*)(hst + l * 144 + (32 * et + 8 * g4 + 4 * hh) * 2) = w; }
        LDS_WAIT();
        {
            const int tt = lt;
#pragma unroll
            for (int ks = 0; ks < 4; ++ks) {
                const int tok = 32 * tt + l31, chh = 16 * ks + 8 * hh, ch = h * 64 + chh;
                const v4u hw = *(const LAS v4u*)(hst + tok * 144 + chh * 2); const v4u ow = *(const v4u*)(P + (row0 + tok) * PW + PC_MO + ch); const v4u cwv = __builtin_bit_cast(v4u, cf[tt][ks]);
                float hv[8], ov[8], cv[8]; unpack8(hw, hv); unpack8(ow, ov); unpack8(cwv, cv);
                const f32x4 g0 = *(const f32x4*)(mnorm + ch), g1 = *(const f32x4*)(mnorm + ch + 4), k0 = *(const f32x4*)(mskip + ch), k1 = *(const f32x4*)(mskip + ch + 4);
                float r[8];
#pragma unroll
                for (int e = 0; e < 8; ++e) { const float gn = e < 4 ? g0[e & 3] : g1[e & 3], sk = e < 4 ? k0[e & 3] : k1[e & 3]; r[e] = sigmoidf_(ov[e]) * (hv[e] * gn + sk * cv[e]); }
                v4u o; o.x = pk2(r[0], r[1]); o.y = pk2(r[2], r[3]); o.z = pk2(r[4], r[5]); o.w = pk2(r[6], r[7]);
                *(v4u*)(Y + (row0 + tok) * 1024 + ch) = o;
            }
        }
        __builtin_amdgcn_sched_barrier(0);
    }
}

DI float gelu_tanh_(float x) { const float u = 0.7978845608028654f * (x + 0.044715f * x * x * x); const float t = 1.0f - 2.0f / (1.0f + __expf(2.0f * u)); return 0.5f * x * (1.0f + t); }

constexpr int XS_PITCH = 272, ZT_PITCH = 528;
constexpr int S5L_XS = 0, S5L_Z = 8 * 32 * XS_PITCH, S5L_OUT = 0, S5L_END = S5L_Z + 64 * ZT_PITCH;
static_assert(S5L_END <= RING_BYTES, "S5 LDS map");
DI void s5_out_unit(Frame& F, int tid_p, const bf16* __restrict__ P, const bf16* __restrict__ bbL  , const bf16* __restrict__ ccL  , const float* __restrict__ abL  ,
                    const float* __restrict__ dskip  , const bf16* __restrict__ gluT  , const float* __restrict__ bglu, const float* __restrict__ onorm, const float* __restrict__ S5ST,
                    bf16* __restrict__ Y, int b, int c, unsigned* dbg_chk = nullptr) {
    const int lane = tid_p & 63, wave = __builtin_amdgcn_readfirstlane(tid_p >> 6), l31 = lane & 31, hh = lane >> 5, l15 = lane & 15, lq = lane >> 4;
    const size_t row0 = (size_t)b * SEQ + (size_t)c * 64;
    LAS unsigned char* xs = F.lds + S5L_XS + wave * 32 * XS_PITCH; LAS unsigned char* zt = F.lds + S5L_Z; LAS unsigned char* ot = F.lds + S5L_OUT;
#if DBG_S5_LDSFILL
    for (int i = tid_p; i < S5L_END / 4; i += 512) ((LAS unsigned*)F.lds)[i] = 0u;
    __syncthreads();
#endif
    unsigned hW = 0u, hR = 0u, hY = 0u, hB = 0u;
#pragma unroll 1
    for (int gi = 0; gi < 2; ++gi) {
        const int g = wave * 2 + gi;
        float cr[2], ci[2], ar[2], ai[2];
#pragma unroll
        for (int pt = 0; pt < 2; ++pt) { const float* abp = abL + ((size_t)g * 64 + 32 * pt + l31) * 6; ar[pt] = abp[0]; ai[pt] = abp[1];
            const f32x2 cin = *(const f32x2*)(S5ST + ((((size_t)b * 256 + c) * 16 + g) * 64 + 32 * pt + l31) * 2); cr[pt] = DBG_S5_NOCARRY ? 0.f : cin.x; ci[pt] = DBG_S5_NOCARRY ? 0.f : cin.y;
            hB = hB * 31u + __float_as_uint(cin.x) + 3u * __float_as_uint(cin.y); hR = hR * 31u + __float_as_uint(ar[pt]) + 3u * __float_as_uint(ai[pt]);
            if (DBG_S5_SYNTH == 2) { cr[pt] = 0.01f * (float)((c + l31 + g) & 15); ci[pt] = -0.005f * (float)((c + pt) & 7); } }
        bf16x8 cfr[4];
#pragma unroll
        for (int ks = 0; ks < 4; ++ks) cfr[ks] = *(const bf16x8*)(ccL + ((size_t)g * 16 + l15) * 128 + 32 * ks + 8 * lq);
        const bf16* bbg = bbL + (size_t)g * 2048;
#pragma unroll
        for (int tt = 0; tt < 2; ++tt) {
            const bf16x8 uaf = *(const bf16x8*)(P + (row0 + 32 * tt + l31) * PW + PC_SU + g * 16 + 8 * hh);
#pragma unroll
            for (int pt = 0; pt < 2; ++pt) {
                const f32x16 z16 = {0.f, 0.f, 0.f, 0.f, 0.f, 0.f, 0.f, 0.f, 0.f, 0.f, 0.f, 0.f, 0.f, 0.f, 0.f, 0.f};
                f32x16 bre = MFMA32(uaf, *(const bf16x8*)(bbg + (32 * pt + l31) * 16 + 8 * hh), z16); f32x16 bim_ = MFMA32(uaf, *(const bf16x8*)(bbg + (64 + 32 * pt + l31) * 16 + 8 * hh), z16);
                asm volatile("s_nop 15\n\ts_nop 15\n\ts_nop 15\n\ts_nop 15" : "+v"(bre), "+v"(bim_) :: "memory"); const f32x16 bim = bim_;
#if DBG_S5_TWICE
                for (int i_ = 0; i_ < 16; ++i_) hY = hY * 31u + __float_as_uint(bre[i_]) + 7u * __float_as_uint(bim[i_]);
#endif
#pragma unroll
                for (int q4 = 0; q4 < 4; ++q4) {
                    float y0r[4], y0i[4], y1r[4], y1i[4];
                    float xr = cr[pt], xi = ci[pt];
#if DBG_S5_TWICE
                    hR = hR * 31u + __float_as_uint(xr) + 3u * __float_as_uint(xi) + 5u * __float_as_uint(ar[pt]) + 7u * __float_as_uint(ai[pt]);
                    for (int j_ = 0; j_ < 4; ++j_) hR = hR * 31u + __float_as_uint(bre[4 * q4 + j_]) + 3u * __float_as_uint(bim[4 * q4 + j_]);
#endif
#pragma unroll
                    for (int j = 0; j < 4; ++j) { float nr, ni; CSTEP(nr, ni, ar[pt], ai[pt], xr, xi, bre[4 * q4 + j], bim[4 * q4 + j]); xr = nr; xi = ni; y0r[j] = nr; y0i[j] = ni; }
#if DBG_S5_TWICE
                    for (int j_ = 0; j_ < 4; ++j_) hB = hB * 31u + __float_as_uint(y0r[j_]) + 3u * __float_as_uint(y0i[j_]);
#endif
                    if (!DBG_S5_NOPERM) { xr = shl_from(xr, l31); xi = shl_from(xi, l31); }
#pragma unroll
                    for (int j = 0; j < 4; ++j) { float nr, ni; CSTEP(nr, ni, ar[pt], ai[pt], xr, xi, bre[4 * q4 + j], bim[4 * q4 + j]); xr = nr; xi = ni; y1r[j] = nr; y1i[j] = ni; }
                    if (!DBG_S5_NOPERM) { cr[pt] = shl_from(xr, 32 + l31); ci[pt] = shl_from(xi, 32 + l31); }
#pragma unroll
                    for (int j = 0; j < 4; ++j) { const int tok = 8 * q4 + 4 * hh + j; const float vr = hh ? y1r[j] : y0r[j], vi = hh ? y1i[j] : y0i[j];
                        const unsigned pw_ = pk2(vr, vi); hW = hW * 31u + pw_; *(LAS unsigned*)(xs + tok * XS_PITCH + (32 * pt + l31) * 4) = pw_; }
                }
                asm volatile("" : "+v"(cr[pt]), "+v"(ci[pt]));
            }
            LDS_WAIT();
#pragma unroll
            for (int mt = 0; mt < 2; ++mt) {
                f32x4 ya = {0.f, 0.f, 0.f, 0.f};
#pragma unroll
                for (int ks = 0; ks < 4; ++ks) { const bf16x8 xf = *(const LAS bf16x8*)(xs + (16 * mt + l15) * XS_PITCH + (32 * ks + 8 * lq) * 2); ya = MFMA16(cfr[ks], xf, ya); }
                const int tok = 32 * tt + 16 * mt + l15;
                const f32x4 dsk = *(const f32x4*)(dskip + g * 16 + 4 * lq); const v2u uw = *(const v2u*)(P + (row0 + tok) * PW + PC_SU + g * 16 + 4 * lq);
                v2u zw; zw.x = pk2(gelu_tanh_(ya[0] + dsk[0] * bflo(uw.x)), gelu_tanh_(ya[1] + dsk[1] * bfhi(uw.x))); zw.y = pk2(gelu_tanh_(ya[2] + dsk[2] * bflo(uw.y)), gelu_tanh_(ya[3] + dsk[3] * bfhi(uw.y)));
                *(LAS v2u*)(zt + tok * ZT_PITCH + (g * 16 + 4 * lq) * 2) = zw;
            }
            LDS_WAIT();
        }
    }
    __syncthreads();
#if DBG_S5_TWICE
    if (dbg_chk) { dbg_chk[512 + tid_p] = hW; dbg_chk[1024 + tid_p] = hR; dbg_chk[1536 + tid_p] = hY; dbg_chk[2048 + tid_p] = hB; }
    if (dbg_chk) { unsigned x = 0u; for (int i = tid_p; i < 64 * 128; i += 512) { const int r = i >> 7, cdw = i & 127; x ^= *(const LAS unsigned*)(zt + r * ZT_PITCH + cdw * 4) * (unsigned)(i * 2654435761u + 1u); } dbg_chk[tid_p] = x; }
#endif
    {
        const f32x16 z16 = {0.f, 0.f, 0.f, 0.f, 0.f, 0.f, 0.f, 0.f, 0.f, 0.f, 0.f, 0.f, 0.f, 0.f, 0.f, 0.f};
        f32x16 ga[2] = {z16, z16}; const int nrow = 32 * wave + l31;
#pragma unroll 4
        for (int ks = 0; ks < 16; ++ks) { const bf16x8 wfr = *(const bf16x8*)(gluT + (size_t)nrow * 256 + 16 * ks + 8 * hh);
#pragma unroll
            for (int tt = 0; tt < 2; ++tt) { const bf16x8 zf = *(const LAS bf16x8*)(zt + (32 * tt + l31) * ZT_PITCH + (16 * ks + 8 * hh) * 2); ga[tt] = MFMA32(wfr, zf, ga[tt]); } }
#pragma unroll
        for (int tt = 0; tt < 2; ++tt) { const int tok = 32 * tt + l31;
#pragma unroll
            for (int q = 0; q < 4; ++q) { const int n0 = 32 * wave + 8 * q + 4 * hh; const f32x4 bg = *(const f32x4*)(bglu + n0); const v2u zw = *(const LAS v2u*)(zt + tok * ZT_PITCH + n0 * 2);
                v2u ow; ow.x = pk2(bflo(zw.x) * sigmoidf_(ga[tt][4 * q] + bg[0]), bfhi(zw.x) * sigmoidf_(ga[tt][4 * q + 1] + bg[1])); ow.y = pk2(bflo(zw.y) * sigmoidf_(ga[tt][4 * q + 2] + bg[2]), bfhi(zw.y) * sigmoidf_(ga[tt][4 * q + 3] + bg[3]));
                *(LAS v2u*)(ot + tok * 512 + n0 * 2) = ow; } }
    }
    __syncthreads();
#pragma unroll 1
    for (int k = 0; k < 8; ++k) { const int tok = wave * 8 + k; const v2u w = *(const LAS v2u*)(ot + tok * 512 + lane * 8);
        const float a0 = bflo(w.x), a1 = bfhi(w.x), a2 = bflo(w.y), a3 = bfhi(w.y);
        const float rn = 1.0f / sqrtf(wave_sum((a0 * a0 + a1 * a1) + (a2 * a2 + a3 * a3), lane) * (1.0f / 256.0f) + RMS_EPS);
        const f32x4 gn = *(const f32x4*)(onorm + lane * 4); v2u o; o.x = pk2(a0 * rn * gn[0], a1 * rn * gn[1]); o.y = pk2(a2 * rn * gn[2], a3 * rn * gn[3]);
        *(v2u*)(Y + (row0 + tok) * 1024 + 256 + lane * 4) = o; }
    __syncthreads();
}
DI void attn_merge_row(const bf16* __restrict__ OP, const float* __restrict__ LSE, const float* __restrict__ anorm, bf16* __restrict__ Y, size_t row, int lane) {
    asm volatile("" : "+v"(lane));
    const int h = lane >> 3;
    const float l0 = LSE[row * 8 + h], l1 = LSE[((size_t)T + row) * 8 + h], l2 = LSE[((size_t)2 * T + row) * 8 + h];
    const float mx = fmaxf(l0, fmaxf(l1, l2)); const float e0 = __builtin_amdgcn_exp2f(l0 - mx), e1 = __builtin_amdgcn_exp2f(l1 - mx), e2 = __builtin_amdgcn_exp2f(l2 - mx); const float rsum = 1.0f / (e0 + e1 + e2);
    const v4u a = *(const v4u*)(OP + row * 512 + lane * 8), bq = *(const v4u*)(OP + ((size_t)T + row) * 512 + lane * 8), cq = *(const v4u*)(OP + ((size_t)2 * T + row) * 512 + lane * 8);
    float fa[8], fb[8], fc[8], r[8]; unpack8(a, fa); unpack8(bq, fb); unpack8(cq, fc); float ss = 0.f;
#pragma unroll
    for (int e = 0; e < 8; ++e) { r[e] = (e0 * fa[e] + e1 * fb[e] + e2 * fc[e]) * rsum; ss += r[e] * r[e]; }
    const float rn = 1.0f / sqrtf(wave_sum(ss, lane) * (1.0f / 512.0f) + RMS_EPS);
    const f32x4 g0 = *(const f32x4*)(anorm + lane * 8), g1 = *(const f32x4*)(anorm + lane * 8 + 4);
    v4u o; o.x = pk2(r[0] * rn * g0[0], r[1] * rn * g0[1]); o.y = pk2(r[2] * rn * g0[2], r[3] * rn * g0[3]); o.z = pk2(r[4] * rn * g1[0], r[5] * rn * g1[1]); o.w = pk2(r[6] * rn * g1[2], r[7] * rn * g1[3]);
    *(v4u*)(Y + row * 1024 + 512 + lane * 8) = o;
}
DI void xattn_task(const bf16* __restrict__ Q, const bf16* __restrict__ Km  , const bf16* __restrict__ Vt  , bf16* __restrict__ OX, int b, int hd, int qt, int lane) {
    asm volatile("" : "+v"(lane));
    const int l31 = lane & 31, hh = lane >> 5;
    const size_t qrow = (size_t)b * SEQ + 32 * qt + l31;
    const f32x16 z16 = {0.f, 0.f, 0.f, 0.f, 0.f, 0.f, 0.f, 0.f, 0.f, 0.f, 0.f, 0.f, 0.f, 0.f, 0.f, 0.f};
    bf16x8 qf[16];
#pragma unroll
    for (int ks = 0; ks < 16; ++ks) qf[ks] = *(const bf16x8*)(Q + qrow * 1024 + hd * 256 + 16 * ks + 8 * hh);
    f32x16 s[8];
#pragma unroll
    for (int j = 0; j < 8; ++j) {
        const bf16* kp = Km + ((size_t)b * 256 + 32 * j + l31) * 1024 + hd * 256 + 8 * hh; f32x16 a = z16;
#pragma unroll
        for (int ks = 0; ks < 16; ++ks) a = MFMA32(*(const bf16x8*)(kp + 16 * ks), qf[ks], a);
        s[j] = a;
    }
    float m = -3.0e38f;
#pragma unroll
    for (int j = 0; j < 8; ++j)
#pragma unroll
        for (int i = 0; i < 16; ++i) m = fmaxf(m, s[j][i]);
    m = fmaxf(m, shx(m, 32, lane));
    float lsum = 0.f;
#pragma unroll
    for (int j = 0; j < 8; ++j)
#pragma unroll
        for (int i = 0; i < 16; ++i) { const float p = __expf(s[j][i] - m); s[j][i] = p; lsum += p; }
    lsum += shx(lsum, 32, lane);
    const float inv = 1.0f / lsum;
    bf16x8 pf[8][2];
#pragma unroll
    for (int j = 0; j < 8; ++j) { const f32x16 x = s[j] * inv; pf[j][0] = packstep(x, 0); pf[j][1] = packstep(x, 1); }
#pragma unroll 1
    for (int nh = 0; nh < 2; ++nh) {
        f32x16 o[4] = {z16, z16, z16, z16};
#pragma unroll
        for (int j = 0; j < 8; ++j)
#pragma unroll
            for (int sp = 0; sp < 2; ++sp)
#pragma unroll
                for (int nt = 0; nt < 4; ++nt) {
                    const bf16* vp = Vt + ((size_t)b * 1024 + hd * 256 + nh * 128 + 32 * nt + l31) * 256 + 32 * j + 16 * sp + 4 * hh;
                    const v2u lo = *(const v2u*)vp, hi = *(const v2u*)(vp + 8);
                    const v4u bw = {lo.x, lo.y, hi.x, hi.y};
                    o[nt] = MFMA32(pf[j][sp], __builtin_bit_cast(bf16x8, bw), o[nt]);
                }
#pragma unroll
        for (int nt = 0; nt < 4; ++nt)
#pragma unroll
            for (int i = 0; i < 16; ++i) OX[((size_t)b * SEQ + 32 * qt + crow(i, hh)) * 1024 + hd * 256 + nh * 128 + 32 * nt + l31] = f2bf(o[nt][i]);
    }
}


DI void xattn_stage(LAS unsigned char* lds, const bf16* __restrict__ src, size_t row_pitch, int tid) {
    asm volatile("" : "+v"(tid));
    v4u w[16];
#pragma unroll
    for (int i = 0; i < 16; ++i) { const int idx = tid + 512 * i, r = idx >> 5, c = idx & 31; w[i] = *(const v4u*)(src + (size_t)r * row_pitch + c * 8); }
#pragma unroll
    for (int i = 0; i < 16; ++i) { const int idx = tid + 512 * i, r = idx >> 5, c = idx & 31; *(LAS v4u*)(lds + r * 512 + ((c ^ (r & 31)) << 4)) = w[i]; }
}
DI void xattn_unit(LAS unsigned char* lds, int tid, const bf16* __restrict__ Q, const bf16* __restrict__ Km  , const bf16* __restrict__ Vt  , bf16* __restrict__ OX, int b, int hd, int qb) {
    const int lane = tid & 63, wave = __builtin_amdgcn_readfirstlane(tid >> 6), l31 = lane & 31, hh = lane >> 5;
    const f32x16 z16 = {0.f, 0.f, 0.f, 0.f, 0.f, 0.f, 0.f, 0.f, 0.f, 0.f, 0.f, 0.f, 0.f, 0.f, 0.f, 0.f};
    xattn_stage(lds, Km + (size_t)b * 256 * 1024 + hd * 256, 1024, tid);
    const size_t qrow0 = (size_t)b * SEQ + (size_t)qb * 256 + wave * 32;
    bf16x8 qf[16];
#pragma unroll
    for (int ks = 0; ks < 16; ++ks) qf[ks] = *(const bf16x8*)(Q + (qrow0 + l31) * 1024 + hd * 256 + 16 * ks + 8 * hh);
    __syncthreads();
    f32x16 s[8];
#pragma unroll
    for (int j = 0; j < 8; ++j) { const int row = 32 * j + l31; const LAS unsigned char* rp = lds + row * 512; f32x16 a = z16;
#pragma unroll
        for (int ks = 0; ks < 16; ++ks) a = MFMA32(*(const LAS bf16x8*)(rp + (((2 * ks + hh) ^ l31) << 4)), qf[ks], a);
        s[j] = a; }
    float m = -3.0e38f;
#pragma unroll
    for (int j = 0; j < 8; ++j)
#pragma unroll
        for (int i = 0; i < 16; ++i) m = fmaxf(m, s[j][i]);
    m = fmaxf(m, shx(m, 32, lane));
    float lsum = 0.f;
#pragma unroll
    for (int j = 0; j < 8; ++j)
#pragma unroll
        for (int i = 0; i < 16; ++i) { const float p = __expf(s[j][i] - m); s[j][i] = p; lsum += p; }
    lsum += shx(lsum, 32, lane);
    const float inv = 1.0f / lsum;
    bf16x8 pf[8][2];
#pragma unroll
    for (int j = 0; j < 8; ++j) { const f32x16 x = s[j] * inv; pf[j][0] = packstep(x, 0); pf[j][1] = packstep(x, 1); }
    __syncthreads();
    xattn_stage(lds, Vt + ((size_t)b * 1024 + hd * 256) * 256, 256, tid);
    __syncthreads();
#pragma unroll 1
    for (int nh = 0; nh < 2; ++nh) {
        f32x16 o[4] = {z16, z16, z16, z16};
#pragma unroll
        for (int j = 0; j < 8; ++j)
#pragma unroll
            for (int sp = 0; sp < 2; ++sp)
#pragma unroll
                for (int nt = 0; nt < 4; ++nt) {
                    const int row = nh * 128 + 32 * nt + l31; const LAS unsigned char* rp = lds + row * 512 + 8 * hh; const int c = 4 * j + 2 * sp;
                    const v2u lo = *(const LAS v2u*)(rp + ((c ^ l31) << 4)), hi = *(const LAS v2u*)(rp + (((c + 1) ^ l31) << 4));
                    const v4u bw = {lo.x, lo.y, hi.x, hi.y};
                    o[nt] = MFMA32(pf[j][sp], __builtin_bit_cast(bf16x8, bw), o[nt]);
                }
#pragma unroll
        for (int nt = 0; nt < 4; ++nt)
#pragma unroll
            for (int i = 0; i < 16; ++i) OX[(qrow0 + crow(i, hh)) * 1024 + hd * 256 + nh * 128 + 32 * nt + l31] = f2bf(o[nt][i]);
    }
    __syncthreads();
}

DI void router_task(const bf16* __restrict__ X, const bf16* __restrict__ wr  , const float* __restrict__ ssq, const float* __restrict__ bg, const float* __restrict__ be, LAS float* lg  ,
                    unsigned* ecnt  , int* __restrict__ TOKE, int* __restrict__ TOKP, float* __restrict__ TOKG, float* __restrict__ TRS, int t0, int lane) {
    asm volatile("" : "+v"(lane));
    const int l31 = lane & 31, hh = lane >> 5;
    const f32x16 z16 = {0.f, 0.f, 0.f, 0.f, 0.f, 0.f, 0.f, 0.f, 0.f, 0.f, 0.f, 0.f, 0.f, 0.f, 0.f, 0.f};
    f32x16 a0 = z16, a1 = z16;
    const bf16* xp = X + (size_t)(t0 + l31) * 1024 + 8 * hh; const bf16* w0 = wr + (size_t)l31 * 1024 + 8 * hh; const bf16* w1 = wr + (size_t)(32 + l31) * 1024 + 8 * hh;
#pragma unroll 8
    for (int ks = 0; ks < 64; ++ks) { const bf16x8 af = *(const bf16x8*)(xp + 16 * ks); a0 = MFMA32(af, *(const bf16x8*)(w0 + 16 * ks), a0); a1 = MFMA32(af, *(const bf16x8*)(w1 + 16 * ks), a1); }
#pragma unroll
    for (int i = 0; i < 16; ++i) { lg[crow(i, hh) * 40 + l31] = a0[i]; if (l31 < 4) lg[crow(i, hh) * 40 + 32 + l31] = a1[i]; }
    LDS_WAIT();
    if (lane < 32) {
        const int t = t0 + lane; const float rs = 1.0f / sqrtf(pg8::ssq16(ssq + (size_t)t * 16) * (1.0f / 1024.0f) + RMS_EPS);
        const LAS float* lr = lg + lane * 40;
        float gl[4]; int gi = 0; float gm = -3.0e38f;
#pragma unroll
        for (int k = 0; k < 4; ++k) { gl[k] = lr[k] * rs + bg[k]; if (gl[k] > gm) { gm = gl[k]; gi = k; } }
        float gs = 0.f;
#pragma unroll
        for (int k = 0; k < 4; ++k) gs += __expf(gl[k] - gm);
        const float gp = 1.0f / gs;
        float el[8]; int i0 = 0; float m0 = -3.0e38f;
#pragma unroll
        for (int k = 0; k < 8; ++k) { el[k] = lr[4 + gi * 8 + k] * rs + be[gi * 8 + k]; if (el[k] > m0) { m0 = el[k]; i0 = k; } }
        int i1 = 0; float m1 = -3.0e38f;
#pragma unroll
        for (int k = 0; k < 8; ++k) if (k != i0 && el[k] > m1) { m1 = el[k]; i1 = k; }
        const float p1 = __expf(m1 - m0); const float g0 = gp / (1.0f + p1), g1 = gp * p1 / (1.0f + p1);
        const int e0 = gi * 8 + i0, e1 = gi * 8 + i1;
        const int pos0 = (int)__hip_atomic_fetch_add(ecnt + e0, 1u, RLX_AGENT), pos1 = (int)__hip_atomic_fetch_add(ecnt + e1, 1u, RLX_AGENT);
        TOKE[t * 2] = e0; TOKE[t * 2 + 1] = e1; TOKP[t * 2] = pos0; TOKP[t * 2 + 1] = pos1; TOKG[t * 2] = g0; TOKG[t * 2 + 1] = g1; TRS[t] = rs;
    }
    LDS_WAIT();
}
DI void moe_tile_prefix(Frame& F, const unsigned* ecnt, int tid_p) {
    LAS int* tp = (LAS int*)(F.lds + TP_OFF);
    if (tid_p == 0) { int acc = 0;
#pragma unroll 1
        for (int e = 0; e < 32; ++e) { tp[e] = acc; int cn = (int)__hip_atomic_load(ecnt + e, RLX_AGENT); cn = cn < 0 ? 0 : (cn > 65536 ? 65536 : cn); acc += (cn + 255) >> 8; acc = acc > XS_ROWS / 256 ? XS_ROWS / 256 : acc; }
        tp[32] = acc; }
    __syncthreads();
}
#ifndef DBG_SKIP_MIX
#define DBG_SKIP_MIX 0
#endif
#ifndef DBG_SKIP_XATTN
#define DBG_SKIP_XATTN 0
#endif
#ifndef DBG_NO_ATTN
#define DBG_NO_ATTN 0
#endif
#ifndef DBG_NO_MLSTM
#define DBG_NO_MLSTM 0
#endif
#ifndef DBG_NO_S5
#define DBG_NO_S5 0
#endif
#ifndef DBG_S5_NOSCAN
#define DBG_S5_NOSCAN 0
#endif
#ifndef DBG_S5_TWICE
#define DBG_S5_TWICE 0
#endif
#ifndef DBG_DUP
#define DBG_DUP 0
#endif
#ifndef DBG_SKIP_MOE
#define DBG_SKIP_MOE 0
#endif
constexpr int PH2_IMG = 0, PH2_CW = 20480, PH2_VST = 25600, PH2_WSC = 62464;
constexpr int PH4_CW = 0, PH4_WSC = 5120, PH4_HST = 13312;

__global__ void __launch_bounds__(NWAVES * 64, 2) fwd_kernel(Args args) {
    extern __shared__ __attribute__((aligned(16))) unsigned char lds[];
    Frame F;
    F.lds = (LAS unsigned char*)lds;
    F.tid = threadIdx.x; F.lane = F.tid & 63; F.wave = __builtin_amdgcn_readfirstlane(F.tid >> 6);
    F.G = gridDim.x; { const int bx = blockIdx.x; F.vcu = (F.G % 8 == 0) ? (bx % 8) * (F.G / 8) + bx / 8 : bx; }
    F.ctl = (gu32*)(args.ws + WS_CTL);
    const int wave_u = F.wave;
    volatile LAS unsigned* MISC = (volatile LAS unsigned*)(F.lds + MISC_OFF);
    for (int u = F.tid; u < (LDS_BYTES - LDSCTL_OFF) / 4; u += NWAVES * 64) ((LAS unsigned*)(F.lds + LDSCTL_OFF))[u] = 0u;
    __syncthreads();
    XcdBarrier bar = xcd_barrier_post((unsigned*)(F.ctl + CW_BAR), MISC + 8);
#define GRID_BAR() do { XcdBarrier b2_ = bar; size_t bo_ = 0; asm volatile("" : "+s"(b2_.x), "+s"(bo_)); b2_.bar = bar.bar + bo_; xcd_barrier(b2_); } while (0)
    const int NGW = F.G * NWAVES;
#define Xb ((bf16*)(ws + WS_X))
#define Pb ((bf16*)(ws + WS_P))
#define Yb ((bf16*)(ws + WS_Y))
#define OPb ((bf16*)(ws + WS_OP))
#define RSA ((float*)(ws + WS_RSA))
#define SSQ ((float*)(ws + WS_SSQ))
#define Gt ((float*)(ws + WS_G))
#define LSE ((float*)(ws + WS_LSE))
#define S5ST ((float*)(ws + WS_S5ST))
#define MST ((float*)(ws + WS_MST))
#define MSC ((float*)(ws + WS_MISC + MI_MSC))
#define MPREV ((float*)(ws + WS_MISC + MI_MPREV))
#define TOKE ((int*)(ws + WS_MISC + MI_TOKE))
#define TOKP ((int*)(ws + WS_MISC + MI_TOKP))
#define TOKG ((float*)(ws + WS_MISC + MI_TOKG))
#define TRS ((float*)(ws + WS_MISC + MI_TRS))
#define RT ((int*)(ws + WS_MISC + MI_RT))
#define RGATE ((float*)(ws + WS_MISC + MI_RGATE))
#define RSS ((float*)(ws + WS_MISC + MI_RSS))
    if (F.tid < 40) ((const void**)(args.ws + WS_MISC + MI_PTAB))[F.tid] = F.tid < 39 ? (const void*)args.in[F.tid] : (const void*)args.out;
#pragma unroll 1
    for (int dup_ = 0; dup_ < (DBG_DUP & 1) + 1; ++dup_) { p0_prologue(F, args); __syncthreads(); }
    GRID_BAR();

#define PIN(k) (((const float* const*)(ws + WS_MISC + MI_PTAB))[k])
#define PHASE_IDS() int lane; asm volatile("v_mbcnt_lo_u32_b32 %0, -1, 0\n\tv_mbcnt_hi_u32_b32 %0, -1, %0" : "=v"(lane)); int wave = wave_u; asm volatile("" : "+s"(wave)); \
    const int tid_p = wave * 64 + lane, gw = F.vcu * NWAVES + wave; size_t wsoff_ = 0; asm volatile("" : "+s"(wsoff_)); unsigned char* ws = args.ws + wsoff_; (void)tid_p; (void)gw
    { constexpr int l = 0;
#pragma unroll 1
        for (int dup_ = 0; dup_ < ((DBG_DUP >> 1) & 1) + 1; ++dup_) {
        {
            PHASE_IDS();
            pg8::Gemm g{Xb, (const bf16*)(ws + WS_WIN) + (size_t)l * 2560 * 1024, T, 2560, D}; pg8::StaticOrder S; S.init(T, 2560, F.G, (int)blockIdx.x);
            pg8::EpiA E{Pb, Gt, RSA};
            pg8::gemm_phase<pg8::EpiA, pg8::StaticOrder, true, true>(F.lds + RING_OFF, g, S, E, wave);
        }
        if (l == 0) {
            __syncthreads();
            PHASE_IDS();
            pg8::Gemm g{(const bf16*)(ws + WS_AMEM), (const bf16*)(ws + WS_WKV), 512, 4096, D}; pg8::StaticOrder S; S.init(512, 4096, F.G, (int)blockIdx.x);
            pg8::EpiKV E{(bf16*)(ws + WS_KMEM), (bf16*)(ws + WS_VT)};
            pg8::gemm_phase<pg8::EpiKV, pg8::StaticOrder, true, true>(F.lds + RING_OFF, g, S, E, wave);
        }
        if (dup_ + 1 < ((DBG_DUP >> 1) & 1) + 1) { VM_WAIT(); __syncthreads(); }
        }
        GRID_BAR();
#if !DBG_SKIP_MIX
#pragma unroll 1
        for (int dup_ = 0; dup_ < ((DBG_DUP >> 2) & 1) + 1; ++dup_) {
        {
            PHASE_IDS();
            LAS float* imgL = (LAS float*)(F.lds + PH2_IMG); LAS float* cw = (LAS float*)(F.lds + PH2_CW);
            const int ph = F.vcu % 24, prank = F.vcu / 24, pnwg = (F.G - ph + 23) / 24;
            for (int i = tid_p; i < 5 * 64 * 16; i += NWAVES * 64) imgL[i] = ((const float*)(ws + WS_TAB + TAB_IMG))[ph * 5120 + i];
            for (int i = tid_p; i < 1280; i += NWAVES * 64) cw[i] = i < 1024 ? PIN(I_CONVW)[l * 1024 + i] : PIN(I_CONVB)[l * 256 + i - 1024];
            __syncthreads();
            LAS unsigned char* vst = F.lds + PH2_VST + wave * (32 * VST_PITCH); LAS float* wsc = (LAS float*)(F.lds + PH2_WSC) + wave * 256;
            { const int p = ph >> 3, h = ph & 7; const int dil = p == 0 ? 1 : (p == 1 ? 4 : 16); const int per = 512 / dil;
#pragma unroll 1
            for (int dup2_ = 0; dup2_ < ((DBG_DUP >> 9) & 1) + 1; ++dup2_)
#pragma unroll 1
            for (int tk = prank * NWAVES + wave; tk < (DBG_NO_ATTN ? 0 : 1024); tk += pnwg * NWAVES) {
                const int b = tk >> 9, w = tk & 511;
                dil_attn_task(Pb, OPb + (size_t)p * T * 512, LSE + (size_t)p * T * 8, imgL, vst, dil, b, h, w / per, w % per, lane);
            } }
            const bf16* mlw = (const bf16*)(ws + WS_TAB + TAB_MLW) + (size_t)l * 4 * 3 * 4096;
#pragma unroll 1
            for (int tk = gw; tk < (DBG_NO_MLSTM ? 0 : 2048); tk += NGW) { const int b = tk >> 10, c = (tk >> 2) & 255, h = tk & 3;
                mlstm_b1_task(Pb, Gt, mlw, PIN(I_MGB) + l * 8, cw, wsc, MST, MSC, b, c, h, lane); }
            const bf16* bbL = (const bf16*)(ws + WS_TAB + TAB_S5BB) + (size_t)l * 16 * 2048; const float* abL = (const float*)(ws + WS_TAB + TAB_S5AB) + (size_t)l * 16 * 64 * 6;
#pragma unroll 1
            for (int tk = gw; tk < (DBG_NO_S5 ? 0 : 8192); tk += NGW) { const int b = tk >> 12, c = (tk >> 4) & 255, g = tk & 15;
                s5_end_task(Pb, bbL + (size_t)g * 2048, abL + (size_t)g * 384, S5ST, b, c, g, lane); }
        }
        if (dup_ + 1 < ((DBG_DUP >> 2) & 1) + 1) { VM_WAIT(); __syncthreads(); }
        }
        GRID_BAR();
        {
            PHASE_IDS();
            const int wt = wave * F.G + F.vcu;
            if (!DBG_NO_MLSTM && wt < 520) mlstm_scan_task(MST, MSC, MPREV, wt, lane);
            if (!DBG_NO_S5 && !DBG_S5_NOSCAN && wave == 3 && F.vcu < 32) s5_scan_task(S5ST, (const float*)(ws + WS_TAB + TAB_S5AB) + (size_t)l * 16 * 64 * 6, F.vcu, lane);
        }
        GRID_BAR();
#pragma unroll 1
        for (int dup_ = 0; dup_ < ((DBG_DUP >> 3) & 1) + 1; ++dup_) {
        {
            PHASE_IDS();
            LAS float* cw = (LAS float*)(F.lds + PH4_CW);
            for (int i = tid_p; i < 1280; i += NWAVES * 64) cw[i] = i < 1024 ? PIN(I_CONVW)[l * 1024 + i] : PIN(I_CONVB)[l * 256 + i - 1024];
            __syncthreads();
            const bf16* mlw = (const bf16*)(ws + WS_TAB + TAB_MLW) + (size_t)l * 4 * 3 * 4096;
#pragma unroll 1
            for (int tk = gw; tk < (DBG_NO_MLSTM ? 0 : 2048); tk += NGW) { const int b = tk >> 10, c = (tk >> 2) & 255, h = tk & 3;
                int lane2; asm volatile("v_mbcnt_lo_u32_b32 %0, -1, 0\n\tv_mbcnt_hi_u32_b32 %0, -1, %0" : "=v"(lane2));
                size_t zo_ = 0; asm volatile("" : "+s"(zo_));
                mlstm_b3_task(Pb + zo_, Gt + zo_, mlw + zo_, PIN(I_MGB) + l * 8 + zo_, PIN(I_MNORM) + l * 256 + zo_, PIN(I_MSKIP) + l * 256 + zo_, cw, (LAS float*)(F.lds + PH4_WSC) + wave * 256, F.lds + PH4_HST + wave * 9216, MST + zo_, MPREV + zo_, Yb + zo_, b, c, h, lane2); }
            __syncthreads();
        }
        {
            PHASE_IDS();
#pragma unroll 1
            for (int rep = 0; rep < (DBG_S5_TWICE ? 2 : 1); ++rep)
#pragma unroll 1
            for (int u2 = F.vcu; u2 < (DBG_NO_S5 ? 0 : 512); u2 += F.G)
              { const int u = u2; int ln_; asm volatile("v_mbcnt_lo_u32_b32 %0, -1, 0\n\tv_mbcnt_hi_u32_b32 %0, -1, %0" : "=v"(ln_));
                s5_out_unit(F, wave * 64 + ln_, Pb, (const bf16*)(ws + WS_TAB + TAB_S5BB) + (size_t)l * 16 * 2048, (const bf16*)(ws + WS_TAB + TAB_S5CC) + (size_t)l * 16 * 2048, (const float*)(ws + WS_TAB + TAB_S5AB) + (size_t)l * 16 * 64 * 6,
                            PIN(I_S5D) + l * 256, (const bf16*)(ws + WS_TAB + TAB_GLU) + (size_t)l * 65536, PIN(I_S5BGLU) + l * 256, PIN(I_S5ONORM) + l * 256, S5ST, rep ? (bf16*)(ws + WS_OP) : Yb, u >> 8, u & 255,
                            DBG_S5_TWICE ? (unsigned*)(ws + WS_OP + (rep ? 88 : 80) * MiB) + (size_t)u * 2560 : nullptr); }
#if DBG_S5_TWICE
            VM_WAIT(); __syncthreads();
        }
        {
            PHASE_IDS();
            for (int u = F.vcu; u < 512; u += F.G) { const size_t row0 = (size_t)u * 64;
                for (int i = tid_p; i < 64 * 64; i += 512) { const int r = i >> 6, c4 = i & 63; const v2u a = *(const v2u*)(Yb + (row0 + r) * 1024 + 256 + c4 * 4), b2 = *(const v2u*)((bf16*)(ws + WS_OP) + (row0 + r) * 1024 + 256 + c4 * 4);
                    if (a.x != b2.x || a.y != b2.y) __hip_atomic_store(F.ctl + 3, 1u, RLX_AGENT); }
                for (int k_ = 0; k_ < 5; ++k_) if (((const unsigned*)(ws + WS_OP + 80 * MiB))[(size_t)u * 2560 + k_ * 512 + tid_p] != ((const unsigned*)(ws + WS_OP + 88 * MiB))[(size_t)u * 2560 + k_ * 512 + tid_p]) __hip_atomic_store(F.ctl + 8 + k_, 1u, RLX_AGENT); }
#endif
        }
        {
            PHASE_IDS();
#pragma unroll 1
            for (int r = gw; r < T; r += NGW) {
                if (!DBG_NO_ATTN) attn_merge_row(OPb, LSE, PIN(I_AONORM) + l * 512, Yb, (size_t)r, lane); else *(v4u*)(Yb + (size_t)r * 1024 + 512 + lane * 8) = (v4u){0u, 0u, 0u, 0u};
                if (DBG_NO_MLSTM) *(v2u*)(Yb + (size_t)r * 1024 + lane * 4) = (v2u){0u, 0u};
                if (DBG_NO_S5) *(v2u*)(Yb + (size_t)r * 1024 + 256 + lane * 4) = (v2u){0u, 0u};
            }
        }
        if (dup_ + 1 < ((DBG_DUP >> 3) & 1) + 1) { VM_WAIT(); __syncthreads(); }
        }
        GRID_BAR();
        {
            PHASE_IDS();
            pg8::Gemm g{Yb, (const bf16*)(ws + WS_WOUT) + (size_t)l * 1048576, T, D, D}; pg8::StaticOrder S; S.init(T, D, F.G, (int)blockIdx.x);
            pg8::EpiRes E{Xb, SSQ};
            pg8::gemm_phase<pg8::EpiRes, pg8::StaticOrder, true, true>(F.lds + RING_OFF, g, S, E, wave);
        }
        GRID_BAR();
#else
        { PHASE_IDS();
        for (int m = gw; m < T; m += NGW) { const v4u a = *(const v4u*)(Xb + (size_t)m * D + lane * 16), b2 = *(const v4u*)(Xb + (size_t)m * D + lane * 16 + 8); float fa[8], fb[8]; unpack8(a, fa); unpack8(b2, fb); float s = 0.f;
            for (int e = 0; e < 8; ++e) s += fa[e] * fa[e] + fb[e] * fb[e]; s = wave_sum(s, lane); if (lane < 16) SSQ[(size_t)m * 16 + lane] = lane == 0 ? s : 0.f; } }
        GRID_BAR();
#endif
#if !DBG_SKIP_XATTN
#pragma unroll 1
        for (int dup_ = 0; dup_ < ((DBG_DUP >> 4) & 1) + 1; ++dup_) {
        {
            PHASE_IDS();
            pg8::Gemm g{Xb, (const bf16*)(ws + WS_WQ) + (size_t)l * 1048576, T, D, D}; pg8::StaticOrder S; S.init(T, D, F.G, (int)blockIdx.x);
            pg8::EpiQ E{(bf16*)(ws + WS_Q), SSQ};
            pg8::gemm_phase<pg8::EpiQ, pg8::StaticOrder, true, true>(F.lds + RING_OFF, g, S, E, wave);
        }
        if (dup_ + 1 < ((DBG_DUP >> 4) & 1) + 1) { VM_WAIT(); __syncthreads(); }
        }
        GRID_BAR();
#pragma unroll 1
        for (int dup_ = 0; dup_ < ((DBG_DUP >> 5) & 1) + 1; ++dup_) {
        { PHASE_IDS();
#pragma unroll 1
        for (int u2 = F.vcu; u2 < 512; u2 += F.G) { const int u = u2; int ln_; asm volatile("v_mbcnt_lo_u32_b32 %0, -1, 0\n\tv_mbcnt_hi_u32_b32 %0, -1, %0" : "=v"(ln_));
            xattn_unit(F.lds, wave * 64 + ln_, (const bf16*)(ws + WS_Q), (const bf16*)(ws + WS_KMEM) + (size_t)l * 512 * 1024, (const bf16*)(ws + WS_VT) + (size_t)l * 2 * 1024 * 256, (bf16*)(ws + WS_OX), u >> 8, (u >> 6) & 3, u & 63); } }
        if (dup_ + 1 < ((DBG_DUP >> 5) & 1) + 1) { VM_WAIT(); __syncthreads(); }
        }
        GRID_BAR();
        {
            PHASE_IDS();
            pg8::Gemm g{(const bf16*)(ws + WS_OX), (const bf16*)(ws + WS_WO) + (size_t)l * 1048576, T, D, D}; pg8::StaticOrder S; S.init(T, D, F.G, (int)blockIdx.x);
            pg8::EpiRes E{Xb, SSQ};
            pg8::gemm_phase<pg8::EpiRes, pg8::StaticOrder, true, true>(F.lds + RING_OFF, g, S, E, wave);
        }
        GRID_BAR();
#endif
#if !DBG_SKIP_MOE
        unsigned* ecnt = (unsigned*)(F.ctl + CW_ECNT) + l * 64;
        { PHASE_IDS();
        if (wave < 4) {
#pragma unroll 1
            for (int tk = F.vcu * 4 + wave; tk < T / 32; tk += F.G * 4)
                router_task(Xb, (const bf16*)(ws + WS_WR) + (size_t)l * 65536, SSQ, PIN(I_RBG) + l * 4, PIN(I_RBE) + l * 32, (LAS float*)(F.lds) + wave * 1280, ecnt, TOKE, TOKP, TOKG, TRS, tk * 32, lane);
        } }
        GRID_BAR();
#pragma unroll 1
        for (int dup_ = 0; dup_ < ((DBG_DUP >> 6) & 1) + 1; ++dup_) {
        {
            PHASE_IDS();
            moe_tile_prefix(F, ecnt, tid_p);
            const LAS int* tp = (const LAS int*)(F.lds + TP_OFF);
#pragma unroll 1
            for (int t = gw; t < T; t += NGW) {
                const v4u a = *(const v4u*)(Xb + (size_t)t * D + lane * 8), b2 = *(const v4u*)(Xb + (size_t)t * D + 512 + lane * 8);
#pragma unroll
                for (int k = 0; k < 2; ++k) { const int e = TOKE[t * 2 + k] & 31; int slot = 256 * tp[e] + TOKP[t * 2 + k]; slot = slot < 0 ? 0 : (slot >= XS_ROWS ? XS_ROWS - 1 : slot);
                    bf16* dst = (bf16*)(ws + WS_XS) + (size_t)slot * D; *(v4u*)(dst + lane * 8) = a; *(v4u*)(dst + 512 + lane * 8) = b2;
                    if (lane == 0) { RT[slot] = t * 2 + k; RGATE[slot] = TOKG[t * 2 + k]; RSS[slot] = TRS[t]; } }
            }
            if (F.vcu < 32) { const int e = F.vcu; int lo = 256 * tp[e] + (int)__hip_atomic_load(ecnt + e, RLX_AGENT); const int hi = 256 * tp[e + 1]; lo = lo < 256 * tp[e] ? 256 * tp[e] : lo;
                for (int s = lo + tid_p; s < hi; s += NWAVES * 64) { RT[s] = -1; RGATE[s] = 0.f; RSS[s] = 0.f; } }
        }
        if (dup_ + 1 < ((DBG_DUP >> 6) & 1) + 1) { VM_WAIT(); __syncthreads(); }
        }
        GRID_BAR();
#pragma unroll 1
        for (int dup_ = 0; dup_ < ((DBG_DUP >> 7) & 1) + 1; ++dup_) {
        {
            PHASE_IDS();
            pg8::Gemm g{(const bf16*)(ws + WS_XS), (const bf16*)(ws + WS_WGU) + (size_t)l * 32 * 1048576, XS_ROWS, 32 * 1024, D}; pg8::MoeOrder S{(const LAS int*)(F.lds + TP_OFF), F.G, F.vcu};
            pg8::EpiGU E{(bf16*)(ws + WS_H), RSS};
            pg8::gemm_phase<pg8::EpiGU, pg8::MoeOrder, true, true>(F.lds + RING_OFF, g, S, E, wave);
        }
        if (dup_ + 1 < ((DBG_DUP >> 7) & 1) + 1) { VM_WAIT(); __syncthreads(); }
        }
        GRID_BAR();
#pragma unroll 1
        for (int dup_ = 0; dup_ < ((DBG_DUP >> 8) & 1) + 1; ++dup_) {
        {
            PHASE_IDS();
            pg8::Gemm g{(const bf16*)(ws + WS_H), (const bf16*)(ws + WS_WDN) + (size_t)l * 32 * 524288, XS_ROWS, 32 * 1024, 512}; pg8::MoeOrder S{(const LAS int*)(F.lds + TP_OFF), F.G, F.vcu};
            pg8::EpiDN E{(bf16*)(ws + WS_YP), RT, RGATE};
            pg8::gemm_phase<pg8::EpiDN, pg8::MoeOrder, true, true>(F.lds + RING_OFF, g, S, E, wave);
        }
        if (dup_ + 1 < ((DBG_DUP >> 8) & 1) + 1) { VM_WAIT(); __syncthreads(); }
        }
        GRID_BAR();
#endif
        {
            PHASE_IDS();
            const bf16* Y0 = (const bf16*)(ws + WS_YP); const bf16* Y1 = Y0 + (size_t)T * D; const float* fn = PIN(I_FNORM);
#pragma unroll 1
            for (int t = gw; t < T; t += NGW) {
                float v[16];
                { const v4u a = *(const v4u*)(Xb + (size_t)t * D + lane * 16), b2 = *(const v4u*)(Xb + (size_t)t * D + lane * 16 + 8); float fa[8], fb[8]; unpack8(a, fa); unpack8(b2, fb);
#pragma unroll
                  for (int e = 0; e < 8; ++e) { v[e] = fa[e]; v[8 + e] = fb[e]; } }
#if !DBG_SKIP_MOE
                { const v4u a = *(const v4u*)(Y0 + (size_t)t * D + lane * 16), b2 = *(const v4u*)(Y0 + (size_t)t * D + lane * 16 + 8); float fa[8], fb[8]; unpack8(a, fa); unpack8(b2, fb);
#pragma unroll
                  for (int e = 0; e < 8; ++e) { v[e] += fa[e]; v[8 + e] += fb[e]; } }
                { const v4u a = *(const v4u*)(Y1 + (size_t)t * D + lane * 16), b2 = *(const v4u*)(Y1 + (size_t)t * D + lane * 16 + 8); float fa[8], fb[8]; unpack8(a, fa); unpack8(b2, fb);
#pragma unroll
                  for (int e = 0; e < 8; ++e) { v[e] += fa[e]; v[8 + e] += fb[e]; } }
#endif
                if (l + 1 < NLAYER) {
                    v4u o0, o1; o0.x = pk2(v[0], v[1]); o0.y = pk2(v[2], v[3]); o0.z = pk2(v[4], v[5]); o0.w = pk2(v[6], v[7]); o1.x = pk2(v[8], v[9]); o1.y = pk2(v[10], v[11]); o1.z = pk2(v[12], v[13]); o1.w = pk2(v[14], v[15]);
                    *(v4u*)(Xb + (size_t)t * D + lane * 16) = o0; *(v4u*)(Xb + (size_t)t * D + lane * 16 + 8) = o1;
                    float fa[8], fb[8]; unpack8(o0, fa); unpack8(o1, fb); float s = 0.f;
#pragma unroll
                    for (int e = 0; e < 8; ++e) s += fa[e] * fa[e] + fb[e] * fb[e];
                    s = wave_sum(s, lane); if (lane == 0) RSA[t] = 1.0f / sqrtf(s * (1.0f / D) + RMS_EPS);
                } else {
                    float s = 0.f;
#pragma unroll
                    for (int e = 0; e < 16; ++e) s += v[e] * v[e];
                    const float rs = 1.0f / sqrtf(wave_sum(s, lane) * (1.0f / D) + RMS_EPS) * (!DBG_S5_TWICE ? 1.0f : (__hip_atomic_load(F.ctl + 10, RLX_AGENT) ? __builtin_nanf("") : (__hip_atomic_load(F.ctl + 12, RLX_AGENT) ? 10.0f : (__hip_atomic_load(F.ctl + 11, RLX_AGENT) ? 3.0f : (__hip_atomic_load(F.ctl + 9, RLX_AGENT) ? 0.0f : (__hip_atomic_load(F.ctl + 8, RLX_AGENT) ? -1.0f : 1.0f))))));
#pragma unroll
                    for (int q = 0; q < 4; ++q) { const f32x4 gn = *(const f32x4*)(fn + lane * 16 + 4 * q); f32x4 o = {v[4 * q] * rs * gn[0], v[4 * q + 1] * rs * gn[1], v[4 * q + 2] * rs * gn[2], v[4 * q + 3] * rs * gn[3]};
                        *(f32x4*)(((float*)PIN(39)) + (size_t)t * D + lane * 16 + 4 * q) = o; }
                }
            }
        }
        if (l + 1 < NLAYER) GRID_BAR();
    }
    { constexpr int l = 1;
#pragma unroll 1
        for (int dup_ = 0; dup_ < ((DBG_DUP >> 1) & 1) + 1; ++dup_) {
        {
            PHASE_IDS();
            pg8::Gemm g{Xb, (const bf16*)(ws + WS_WIN) + (size_t)l * 2560 * 1024, T, 2560, D}; pg8::StaticOrder S; S.init(T, 2560, F.G, (int)blockIdx.x);
            pg8::EpiA E{Pb, Gt, RSA};
            pg8::gemm_phase<pg8::EpiA, pg8::StaticOrder, true, true>(F.lds + RING_OFF, g, S, E, wave);
        }
        if (l == 0) {
            __syncthreads();
            PHASE_IDS();
            pg8::Gemm g{(const bf16*)(ws + WS_AMEM), (const bf16*)(ws + WS_WKV), 512, 4096, D}; pg8::StaticOrder S; S.init(512, 4096, F.G, (int)blockIdx.x);
            pg8::EpiKV E{(bf16*)(ws + WS_KMEM), (bf16*)(ws + WS_VT)};
            pg8::gemm_phase<pg8::EpiKV, pg8::StaticOrder, true, true>(F.lds + RING_OFF, g, S, E, wave);
        }
        if (dup_ + 1 < ((DBG_DUP >> 1) & 1) + 1) { VM_WAIT(); __syncthreads(); }
        }
        GRID_BAR();
#if !DBG_SKIP_MIX
#pragma unroll 1
        for (int dup_ = 0; dup_ < ((DBG_DUP >> 2) & 1) + 1; ++dup_) {
        {
            PHASE_IDS();
            LAS float* imgL = (LAS float*)(F.lds + PH2_IMG); LAS float* cw = (LAS float*)(F.lds + PH2_CW);
            const int ph = F.vcu % 24, prank = F.vcu / 24, pnwg = (F.G - ph + 23) / 24;
            for (int i = tid_p; i < 5 * 64 * 16; i += NWAVES * 64) imgL[i] = ((const float*)(ws + WS_TAB + TAB_IMG))[ph * 5120 + i];
            for (int i = tid_p; i < 1280; i += NWAVES * 64) cw[i] = i < 1024 ? PIN(I_CONVW)[l * 1024 + i] : PIN(I_CONVB)[l * 256 + i - 1024];
            __syncthreads();
            LAS unsigned char* vst = F.lds + PH2_VST + wave * (32 * VST_PITCH); LAS float* wsc = (LAS float*)(F.lds + PH2_WSC) + wave * 256;
            { const int p = ph >> 3, h = ph & 7; const int dil = p == 0 ? 1 : (p == 1 ? 4 : 16); const int per = 512 / dil;
#pragma unroll 1
            for (int dup2_ = 0; dup2_ < ((DBG_DUP >> 9) & 1) + 1; ++dup2_)
#pragma unroll 1
            for (int tk = prank * NWAVES + wave; tk < (DBG_NO_ATTN ? 0 : 1024); tk += pnwg * NWAVES) {
                const int b = tk >> 9, w = tk & 511;
                dil_attn_task(Pb, OPb + (size_t)p * T * 512, LSE + (size_t)p * T * 8, imgL, vst, dil, b, h, w / per, w % per, lane);
            } }
            const bf16* mlw = (const bf16*)(ws + WS_TAB + TAB_MLW) + (size_t)l * 4 * 3 * 4096;
#pragma unroll 1
            for (int tk = gw; tk < (DBG_NO_MLSTM ? 0 : 2048); tk += NGW) { const int b = tk >> 10, c = (tk >> 2) & 255, h = tk & 3;
                mlstm_b1_task(Pb, Gt, mlw, PIN(I_MGB) + l * 8, cw, wsc, MST, MSC, b, c, h, lane); }
            const bf16* bbL = (const bf16*)(ws + WS_TAB + TAB_S5BB) + (size_t)l * 16 * 2048; const float* abL = (const float*)(ws + WS_TAB + TAB_S5AB) + (size_t)l * 16 * 64 * 6;
#pragma unroll 1
            for (int tk = gw; tk < (DBG_NO_S5 ? 0 : 8192); tk += NGW) { const int b = tk >> 12, c = (tk >> 4) & 255, g = tk & 15;
                s5_end_task(Pb, bbL + (size_t)g * 2048, abL + (size_t)g * 384, S5ST, b, c, g, lane); }
        }
        if (dup_ + 1 < ((DBG_DUP >> 2) & 1) + 1) { VM_WAIT(); __syncthreads(); }
        }
        GRID_BAR();
        {
            PHASE_IDS();
            const int wt = wave * F.G + F.vcu;
            if (!DBG_NO_MLSTM && wt < 520) mlstm_scan_task(MST, MSC, MPREV, wt, lane);
            if (!DBG_NO_S5 && !DBG_S5_NOSCAN && wave == 3 && F.vcu < 32) s5_scan_task(S5ST, (const float*)(ws + WS_TAB + TAB_S5AB) + (size_t)l * 16 * 64 * 6, F.vcu, lane);
        }
        GRID_BAR();
#pragma unroll 1
        for (int dup_ = 0; dup_ < ((DBG_DUP >> 3) & 1) + 1; ++dup_) {
        {
            PHASE_IDS();
            LAS float* cw = (LAS float*)(F.lds + PH4_CW);
            for (int i = tid_p; i < 1280; i += NWAVES * 64) cw[i] = i < 1024 ? PIN(I_CONVW)[l * 1024 + i] : PIN(I_CONVB)[l * 256 + i - 1024];
            __syncthreads();
            const bf16* mlw = (const bf16*)(ws + WS_TAB + TAB_MLW) + (size_t)l * 4 * 3 * 4096;
#pragma unroll 1
            for (int tk = gw; tk < (DBG_NO_MLSTM ? 0 : 2048); tk += NGW) { const int b = tk >> 10, c = (tk >> 2) & 255, h = tk & 3;
                int lane2; asm volatile("v_mbcnt_lo_u32_b32 %0, -1, 0\n\tv_mbcnt_hi_u32_b32 %0, -1, %0" : "=v"(lane2));
                size_t zo_ = 0; asm volatile("" : "+s"(zo_));
                mlstm_b3_task(Pb + zo_, Gt + zo_, mlw + zo_, PIN(I_MGB) + l * 8 + zo_, PIN(I_MNORM) + l * 256 + zo_, PIN(I_MSKIP) + l * 256 + zo_, cw, (LAS float*)(F.lds + PH4_WSC) + wave * 256, F.lds + PH4_HST + wave * 9216, MST + zo_, MPREV + zo_, Yb + zo_, b, c, h, lane2); }
            __syncthreads();
        }
        {
            PHASE_IDS();
#pragma unroll 1
            for (int rep = 0; rep < (DBG_S5_TWICE ? 2 : 1); ++rep)
#pragma unroll 1
            for (int u2 = F.vcu; u2 < (DBG_NO_S5 ? 0 : 512); u2 += F.G)
              { const int u = u2; int ln_; asm volatile("v_mbcnt_lo_u32_b32 %0, -1, 0\n\tv_mbcnt_hi_u32_b32 %0, -1, %0" : "=v"(ln_));
                s5_out_unit(F, wave * 64 + ln_, Pb, (const bf16*)(ws + WS_TAB + TAB_S5BB) + (size_t)l * 16 * 2048, (const bf16*)(ws + WS_TAB + TAB_S5CC) + (size_t)l * 16 * 2048, (const float*)(ws + WS_TAB + TAB_S5AB) + (size_t)l * 16 * 64 * 6,
                            PIN(I_S5D) + l * 256, (const bf16*)(ws + WS_TAB + TAB_GLU) + (size_t)l * 65536, PIN(I_S5BGLU) + l * 256, PIN(I_S5ONORM) + l * 256, S5ST, rep ? (bf16*)(ws + WS_OP) : Yb, u >> 8, u & 255,
                            DBG_S5_TWICE ? (unsigned*)(ws + WS_OP + (rep ? 88 : 80) * MiB) + (size_t)u * 2560 : nullptr); }
#if DBG_S5_TWICE
            VM_WAIT(); __syncthreads();
        }
        {
            PHASE_IDS();
            for (int u = F.vcu; u < 512; u += F.G) { const size_t row0 = (size_t)u * 64;
                for (int i = tid_p; i < 64 * 64; i += 512) { const int r = i >> 6, c4 = i & 63; const v2u a = *(const v2u*)(Yb + (row0 + r) * 1024 + 256 + c4 * 4), b2 = *(const v2u*)((bf16*)(ws + WS_OP) + (row0 + r) * 1024 + 256 + c4 * 4);
                    if (a.x != b2.x || a.y != b2.y) __hip_atomic_store(F.ctl + 3, 1u, RLX_AGENT); }
                for (int k_ = 0; k_ < 5; ++k_) if (((const unsigned*)(ws + WS_OP + 80 * MiB))[(size_t)u * 2560 + k_ * 512 + tid_p] != ((const unsigned*)(ws + WS_OP + 88 * MiB))[(size_t)u * 2560 + k_ * 512 + tid_p]) __hip_atomic_store(F.ctl + 8 + k_, 1u, RLX_AGENT); }
#endif
        }
        {
            PHASE_IDS();
#pragma unroll 1
            for (int r = gw; r < T; r += NGW) {
                if (!DBG_NO_ATTN) attn_merge_row(OPb, LSE, PIN(I_AONORM) + l * 512, Yb, (size_t)r, lane); else *(v4u*)(Yb + (size_t)r * 1024 + 512 + lane * 8) = (v4u){0u, 0u, 0u, 0u};
                if (DBG_NO_MLSTM) *(v2u*)(Yb + (size_t)r * 1024 + lane * 4) = (v2u){0u, 0u};
                if (DBG_NO_S5) *(v2u*)(Yb + (size_t)r * 1024 + 256 + lane * 4) = (v2u){0u, 0u};
            }
        }
        if (dup_ + 1 < ((DBG_DUP >> 3) & 1) + 1) { VM_WAIT(); __syncthreads(); }
        }
        GRID_BAR();
        {
            PHASE_IDS();
            pg8::Gemm g{Yb, (const bf16*)(ws + WS_WOUT) + (size_t)l * 1048576, T, D, D}; pg8::StaticOrder S; S.init(T, D, F.G, (int)blockIdx.x);
            pg8::EpiRes E{Xb, SSQ};
            pg8::gemm_phase<pg8::EpiRes, pg8::StaticOrder, true, true>(F.lds + RING_OFF, g, S, E, wave);
        }
        GRID_BAR();
#else
        { PHASE_IDS();
        for (int m = gw; m < T; m += NGW) { const v4u a = *(const v4u*)(Xb + (size_t)m * D + lane * 16), b2 = *(const v4u*)(Xb + (size_t)m * D + lane * 16 + 8); float fa[8], fb[8]; unpack8(a, fa); unpack8(b2, fb); float s = 0.f;
            for (int e = 0; e < 8; ++e) s += fa[e] * fa[e] + fb[e] * fb[e]; s = wave_sum(s, lane); if (lane < 16) SSQ[(size_t)m * 16 + lane] = lane == 0 ? s : 0.f; } }
        GRID_BAR();
#endif
#if !DBG_SKIP_XATTN
#pragma unroll 1
        for (int dup_ = 0; dup_ < ((DBG_DUP >> 4) & 1) + 1; ++dup_) {
        {
            PHASE_IDS();
            pg8::Gemm g{Xb, (const bf16*)(ws + WS_WQ) + (size_t)l * 1048576, T, D, D}; pg8::StaticOrder S; S.init(T, D, F.G, (int)blockIdx.x);
            pg8::EpiQ E{(bf16*)(ws + WS_Q), SSQ};
            pg8::gemm_phase<pg8::EpiQ, pg8::StaticOrder, true, true>(F.lds + RING_OFF, g, S, E, wave);
        }
        if (dup_ + 1 < ((DBG_DUP >> 4) & 1) + 1) { VM_WAIT(); __syncthreads(); }
        }
        GRID_BAR();
#pragma unroll 1
        for (int dup_ = 0; dup_ < ((DBG_DUP >> 5) & 1) + 1; ++dup_) {
        { PHASE_IDS();
#pragma unroll 1
        for (int u2 = F.vcu; u2 < 512; u2 += F.G) { const int u = u2; int ln_; asm volatile("v_mbcnt_lo_u32_b32 %0, -1, 0\n\tv_mbcnt_hi_u32_b32 %0, -1, %0" : "=v"(ln_));
            xattn_unit(F.lds, wave * 64 + ln_, (const bf16*)(ws + WS_Q), (const bf16*)(ws + WS_KMEM) + (size_t)l * 512 * 1024, (const bf16*)(ws + WS_VT) + (size_t)l * 2 * 1024 * 256, (bf16*)(ws + WS_OX), u >> 8, (u >> 6) & 3, u & 63); } }
        if (dup_ + 1 < ((DBG_DUP >> 5) & 1) + 1) { VM_WAIT(); __syncthreads(); }
        }
        GRID_BAR();
        {
            PHASE_IDS();
            pg8::Gemm g{(const bf16*)(ws + WS_OX), (const bf16*)(ws + WS_WO) + (size_t)l * 1048576, T, D, D}; pg8::StaticOrder S; S.init(T, D, F.G, (int)blockIdx.x);
            pg8::EpiRes E{Xb, SSQ};
            pg8::gemm_phase<pg8::EpiRes, pg8::StaticOrder, true, true>(F.lds + RING_OFF, g, S, E, wave);
        }
        GRID_BAR();
#endif
#if !DBG_SKIP_MOE
        unsigned* ecnt = (unsigned*)(F.ctl + CW_ECNT) + l * 64;
        { PHASE_IDS();
        if (wave < 4) {
#pragma unroll 1
            for (int tk = F.vcu * 4 + wave; tk < T / 32; tk += F.G * 4)
                router_task(Xb, (const bf16*)(ws + WS_WR) + (size_t)l * 65536, SSQ, PIN(I_RBG) + l * 4, PIN(I_RBE) + l * 32, (LAS float*)(F.lds) + wave * 1280, ecnt, TOKE, TOKP, TOKG, TRS, tk * 32, lane);
        } }
        GRID_BAR();
#pragma unroll 1
        for (int dup_ = 0; dup_ < ((DBG_DUP >> 6) & 1) + 1; ++dup_) {
        {
            PHASE_IDS();
            moe_tile_prefix(F, ecnt, tid_p);
            const LAS int* tp = (const LAS int*)(F.lds + TP_OFF);
#pragma unroll 1
            for (int t = gw; t < T; t += NGW) {
                const v4u a = *(const v4u*)(Xb + (size_t)t * D + lane * 8), b2 = *(const v4u*)(Xb + (size_t)t * D + 512 + lane * 8);
#pragma unroll
                for (int k = 0; k < 2; ++k) { const int e = TOKE[t * 2 + k] & 31; int slot = 256 * tp[e] + TOKP[t * 2 + k]; slot = slot < 0 ? 0 : (slot >= XS_ROWS ? XS_ROWS - 1 : slot);
                    bf16* dst = (bf16*)(ws + WS_XS) + (size_t)slot * D; *(v4u*)(dst + lane * 8) = a; *(v4u*)(dst + 512 + lane * 8) = b2;
                    if (lane == 0) { RT[slot] = t * 2 + k; RGATE[slot] = TOKG[t * 2 + k]; RSS[slot] = TRS[t]; } }
            }
            if (F.vcu < 32) { const int e = F.vcu; int lo = 256 * tp[e] + (int)__hip_atomic_load(ecnt + e, RLX_AGENT); const int hi = 256 * tp[e + 1]; lo = lo < 256 * tp[e] ? 256 * tp[e] : lo;
                for (int s = lo + tid_p; s < hi; s += NWAVES * 64) { RT[s] = -1; RGATE[s] = 0.f; RSS[s] = 0.f; } }
        }
        if (dup_ + 1 < ((DBG_DUP >> 6) & 1) + 1) { VM_WAIT(); __syncthreads(); }
        }
        GRID_BAR();
#pragma unroll 1
        for (int dup_ = 0; dup_ < ((DBG_DUP >> 7) & 1) + 1; ++dup_) {
        {
            PHASE_IDS();
            pg8::Gemm g{(const bf16*)(ws + WS_XS), (const bf16*)(ws + WS_WGU) + (size_t)l * 32 * 1048576, XS_ROWS, 32 * 1024, D}; pg8::MoeOrder S{(const LAS int*)(F.lds + TP_OFF), F.G, F.vcu};
            pg8::EpiGU E{(bf16*)(ws + WS_H), RSS};
            pg8::gemm_phase<pg8::EpiGU, pg8::MoeOrder, true, true>(F.lds + RING_OFF, g, S, E, wave);
        }
        if (dup_ + 1 < ((DBG_DUP >> 7) & 1) + 1) { VM_WAIT(); __syncthreads(); }
        }
        GRID_BAR();
#pragma unroll 1
        for (int dup_ = 0; dup_ < ((DBG_DUP >> 8) & 1) + 1; ++dup_) {
        {
            PHASE_IDS();
            pg8::Gemm g{(const bf16*)(ws + WS_H), (const bf16*)(ws + WS_WDN) + (size_t)l * 32 * 524288, XS_ROWS, 32 * 1024, 512}; pg8::MoeOrder S{(const LAS int*)(F.lds + TP_OFF), F.G, F.vcu};
            pg8::EpiDN E{(bf16*)(ws + WS_YP), RT, RGATE};
            pg8::gemm_phase<pg8::EpiDN, pg8::MoeOrder, true, true>(F.lds + RING_OFF, g, S, E, wave);
        }
        if (dup_ + 1 < ((DBG_DUP >> 8) & 1) + 1) { VM_WAIT(); __syncthreads(); }
        }
        GRID_BAR();
#endif
        {
            PHASE_IDS();
            const bf16* Y0 = (const bf16*)(ws + WS_YP); const bf16* Y1 = Y0 + (size_t)T * D; const float* fn = PIN(I_FNORM);
#pragma unroll 1
            for (int t = gw; t < T; t += NGW) {
                float v[16];
                { const v4u a = *(const v4u*)(Xb + (size_t)t * D + lane * 16), b2 = *(const v4u*)(Xb + (size_t)t * D + lane * 16 + 8); float fa[8], fb[8]; unpack8(a, fa); unpack8(b2, fb);
#pragma unroll
                  for (int e = 0; e < 8; ++e) { v[e] = fa[e]; v[8 + e] = fb[e]; } }
#if !DBG_SKIP_MOE
                { const v4u a = *(const v4u*)(Y0 + (size_t)t * D + lane * 16), b2 = *(const v4u*)(Y0 + (size_t)t * D + lane * 16 + 8); float fa[8], fb[8]; unpack8(a, fa); unpack8(b2, fb);
#pragma unroll
                  for (int e = 0; e < 8; ++e) { v[e] += fa[e]; v[8 + e] += fb[e]; } }
                { const v4u a = *(const v4u*)(Y1 + (size_t)t * D + lane * 16), b2 = *(const v4u*)(Y1 + (size_t)t * D + lane * 16 + 8); float fa[8], fb[8]; unpack8(a, fa); unpack8(b2, fb);
#pragma unroll
                  for (int e = 0; e < 8; ++e) { v[e] += fa[e]; v[8 + e] += fb[e]; } }
#endif
                if (l + 1 < NLAYER) {
                    v4u o0, o1; o0.x = pk2(v[0], v[1]); o0.y = pk2(v[2], v[3]); o0.z = pk2(v[4], v[5]); o0.w = pk2(v[6], v[7]); o1.x = pk2(v[8], v[9]); o1.y = pk2(v[10], v[11]); o1.z = pk2(v[12], v[13]); o1.w = pk2(v[14], v[15]);
                    *(v4u*)(Xb + (size_t)t * D + lane * 16) = o0; *(v4u*)(Xb + (size_t)t * D + lane * 16 + 8) = o1;
                    float fa[8], fb[8]; unpack8(o0, fa); unpack8(o1, fb); float s = 0.f;
#pragma unroll
                    for (int e = 0; e < 8; ++e) s += fa[e] * fa[e] + fb[e] * fb[e];
                    s = wave_sum(s, lane); if (lane == 0) RSA[t] = 1.0f / sqrtf(s * (1.0f / D) + RMS_EPS);
                } else {
                    float s = 0.f;
#pragma unroll
                    for (int e = 0; e < 16; ++e) s += v[e] * v[e];
                    const float rs = 1.0f / sqrtf(wave_sum(s, lane) * (1.0f / D) + RMS_EPS) * (!DBG_S5_TWICE ? 1.0f : (__hip_atomic_load(F.ctl + 10, RLX_AGENT) ? __builtin_nanf("") : (__hip_atomic_load(F.ctl + 12, RLX_AGENT) ? 10.0f : (__hip_atomic_load(F.ctl + 11, RLX_AGENT) ? 3.0f : (__hip_atomic_load(F.ctl + 9, RLX_AGENT) ? 0.0f : (__hip_atomic_load(F.ctl + 8, RLX_AGENT) ? -1.0f : 1.0f))))));
#pragma unroll
                    for (int q = 0; q < 4; ++q) { const f32x4 gn = *(const f32x4*)(fn + lane * 16 + 4 * q); f32x4 o = {v[4 * q] * rs * gn[0], v[4 * q + 1] * rs * gn[1], v[4 * q + 2] * rs * gn[2], v[4 * q + 3] * rs * gn[3]};
                        *(f32x4*)(((float*)PIN(39)) + (size_t)t * D + lane * 16 + 4 * q) = o; }
                }
            }
        }
        if (l + 1 < NLAYER) GRID_BAR();
    }
}

extern "C" void kernel_launch(void* const* d_in, const int* in_sizes, int n_in, void* d_out, int out_size, void* d_ws, size_t ws_size, hipStream_t stream) {
    static int grid = 0;
    if (grid == 0) {
        if (n_in != 39 || in_sizes[0] != T * D || out_size != T * D || ws_size < WS_END) { fprintf(stderr, "kernel_launch: unexpected shapes (n_in %d, in0 %d, out %d, ws %zu; need ws >= %zu); nothing launched\n", n_in, n_in > 0 ? in_sizes[0] : -1, out_size, ws_size, (size_t)WS_END); grid = -1; return; }
        int dev = 0, cus = 0, per_cu = 0;
        if (hipGetDevice(&dev) != hipSuccess || hipDeviceGetAttribute(&cus, hipDeviceAttributeMultiprocessorCount, dev) != hipSuccess) { grid = -1; return; }
        if (hipFuncSetAttribute((const void*)fwd_kernel, hipFuncAttributeMaxDynamicSharedMemorySize, LDS_BYTES) != hipSuccess) { fprintf(stderr, "kernel_launch: hipFuncSetAttribute failed\n"); grid = -1; return; }
        if (hipOccupancyMaxActiveBlocksPerMultiprocessor(&per_cu, (const void*)fwd_kernel, NWAVES * 64, LDS_BYTES) != hipSuccess || per_cu < 1) { fprintf(stderr, "kernel_launch: occupancy query reports %d blocks per CU; nothing launched\n", per_cu); (void)hipGetLastError(); grid = -1; return; }
        grid = cus;
    }
    if (grid < 0) return;
    if (hipMemsetAsync((char*)d_ws + WS_CTL, 0, CTL_ZERO_BYTES, stream) != hipSuccess) return;
    Args a{};
    for (int i = 0; i < 39; ++i) a.in[i] = (const float*)d_in[i];
    a.out = (float*)d_out; a.ws = (unsigned char*)d_ws;
    hipLaunchKernelGGL(fwd_kernel, dim3(grid), dim3(NWAVES * 64), LDS_BYTES, stream, a);
}
```
